# Optimizing an MI355X kernel written in HIP

```python
import math
import jax, jax.numpy as jnp
from jax import lax
import numpy as np

D_MODEL = 1024
BATCH = 4
SEQ = 8192
DEPTH = 4

EPS = 1e-6
PLE_DIM = 256
D_FF = 4 * D_MODEL
N_EVEN = (DEPTH + 1) // 2
N_ODD = DEPTH // 2

S5_WIDTH = D_MODEL // 2
S5_GROUP = 16
S5_GROUPS = S5_WIDTH // S5_GROUP
S5_STATE = 64

HG_WIDTH = D_MODEL // 2
HG_HEADS = 4
HG_DK = HG_WIDTH // HG_HEADS
HG_DV = HG_WIDTH // HG_HEADS
HG_CHUNK = 64

EVEN_IN = S5_WIDTH + 4 * HG_WIDTH

N_Q_HEADS = 16
N_KV_HEADS = 4
HEAD_DIM = D_MODEL // N_Q_HEADS
Q_PER_KV = N_Q_HEADS // N_KV_HEADS
WINDOW = 128
ATT_BLOCK = WINDOW
ODD_IN = (N_Q_HEADS + 2 * N_KV_HEADS) * HEAD_DIM

kernel_name = "hybrid_s5_hgrn2_swa_sink_trunk"


def rms_norm(x, g):
    xf = x.astype(jnp.float32)
    y = xf * lax.rsqrt(jnp.mean(xf * xf, axis=-1, keepdims=True) + EPS)
    return (y * g.astype(jnp.float32)).astype(x.dtype)


def s5_mixer(u, lam_re, lam_im, log_dt, b_re, b_im, c_re, c_im, d_skip, w_glu, b_glu):
    f32 = jnp.float32
    bsz, L, _ = u.shape
    uf = u.astype(f32).reshape(bsz, L, S5_GROUPS, S5_GROUP)
    lr = jnp.minimum(lam_re.astype(f32), -1e-4)
    li = lam_im.astype(f32)
    dt = jnp.exp(log_dt.astype(f32))[:, None]
    mag = jnp.exp(lr * dt)
    ar = mag * jnp.cos(li * dt)
    ai = mag * jnp.sin(li * dt)
    den = lr * lr + li * li
    xr = ar - 1.0
    zr = (xr * lr + ai * li) / den
    zi = (ai * lr - xr * li) / den
    br = b_re.astype(f32)
    bi = b_im.astype(f32)
    bbar_re = zr[..., None] * br - zi[..., None] * bi
    bbar_im = zr[..., None] * bi + zi[..., None] * br
    bu_re = jnp.einsum('blgh,gph->blgp', uf, bbar_re)
    bu_im = jnp.einsum('blgh,gph->blgp', uf, bbar_im)
    a_re = jnp.broadcast_to(ar, bu_re.shape)
    a_im = jnp.broadcast_to(ai, bu_im.shape)

    def combine(e1, e2):
        ar1, ai1, br1, bi1 = e1
        ar2, ai2, br2, bi2 = e2
        return (ar2 * ar1 - ai2 * ai1,
                ar2 * ai1 + ai2 * ar1,
                ar2 * br1 - ai2 * bi1 + br2,
                ar2 * bi1 + ai2 * br1 + bi2)

    _, _, s_re, s_im = lax.associative_scan(combine, (a_re, a_im, bu_re, bu_im), axis=1)
    y = (jnp.einsum('blgp,ghp->blgh', s_re, c_re.astype(f32))
         - jnp.einsum('blgp,ghp->blgh', s_im, c_im.astype(f32))
         + d_skip.astype(f32) * uf)
    z = jax.nn.gelu(y.reshape(bsz, L, S5_WIDTH))
    out = z * jax.nn.sigmoid(z @ w_glu.astype(f32) + b_glu.astype(f32))
    return out.astype(u.dtype)


def hgrn2_mixer(q, f_logit, inp, g, lb, head_norm):
    f32 = jnp.float32
    bsz, L, _ = q.shape
    nc = L // HG_CHUNK
    lbf = lb.astype(f32)
    zf = f_logit.astype(f32)
    log_f = jnp.logaddexp(jnp.log(jnp.maximum(lbf, 1e-30)),
                          jnp.log1p(-lbf) + jax.nn.log_sigmoid(zf))
    k = (1.0 - lbf) * jax.nn.sigmoid(-zf)

    def to_chunks(t, d):
        return t.astype(f32).reshape(bsz, nc, HG_CHUNK, HG_HEADS, d).transpose(1, 0, 3, 2, 4)

    qc = to_chunks(q, HG_DK)
    kc = to_chunks(k, HG_DK)
    vc = to_chunks(inp, HG_DV)
    gc = to_chunks(log_f, HG_DK)
    causal = jnp.tril(jnp.ones((HG_CHUNK, HG_CHUNK), dtype=bool))

    def step(S, xs):
        q_c, k_c, v_c, g_c = xs
        b = jnp.cumsum(g_c, axis=2)
        o_inter = jnp.einsum('bhtk,bhkv->bhtv', q_c * jnp.exp(b), S)
        diff = b[:, :, :, None, :] - b[:, :, None, :, :]
        decay = jnp.exp(jnp.where(causal[None, None, :, :, None], diff, -jnp.inf))
        att = jnp.einsum('bhtk,bhtsk,bhsk->bhts', q_c, decay, k_c)
        o = o_inter + jnp.einsum('bhts,bhsv->bhtv', att, v_c)
        b_last = b[:, :, -1:, :]
        S_new = (jnp.exp(b_last[:, :, 0, :])[..., None] * S
                 + jnp.einsum('bhsk,bhsv->bhkv', k_c * jnp.exp(b_last - b), v_c))
        return S_new, o

    S0 = jnp.zeros((bsz, HG_HEADS, HG_DK, HG_DV), f32)
    _, o = lax.scan(step, S0, (qc, kc, vc, gc))
    o = o.transpose(1, 0, 3, 2, 4).reshape(bsz, L, HG_HEADS, HG_DV)
    o = o * lax.rsqrt(jnp.mean(o * o, axis=-1, keepdims=True) + EPS) * head_norm.astype(f32)
    o = o.reshape(bsz, L, HG_WIDTH) * jax.nn.silu(g.astype(f32))
    return o.astype(q.dtype)


def swa_sink_attention(q, k, v, sinks):
    f32 = jnp.float32
    bsz, L = q.shape[0], q.shape[1]
    nb = L // ATT_BLOCK
    qb = q.reshape(bsz, nb, ATT_BLOCK, N_KV_HEADS, Q_PER_KV, HEAD_DIM)

    def window_blocks(t):
        tp = jnp.pad(t, ((0, 0), (ATT_BLOCK, 0), (0, 0), (0, 0)))
        tb = tp.reshape(bsz, nb + 1, ATT_BLOCK, N_KV_HEADS, HEAD_DIM)
        return jnp.concatenate([tb[:, :-1], tb[:, 1:]], axis=2)

    kw = window_blocks(k)
    vw = window_blocks(v)
    scale = 1.0 / math.sqrt(HEAD_DIM)
    scores = jnp.einsum('bntkgd,bnskd->bnkgts', qb, kw).astype(f32) * scale
    t_loc = jnp.arange(ATT_BLOCK)[:, None] + ATT_BLOCK
    s_loc = jnp.arange(2 * ATT_BLOCK)[None, :]
    dist = t_loc - s_loc
    valid = (dist >= 0) & (dist < WINDOW)
    key_pos = jnp.arange(nb)[:, None] * ATT_BLOCK + jnp.arange(2 * ATT_BLOCK)[None, :] - ATT_BLOCK
    valid = valid[None, :, :] & (key_pos >= 0)[:, None, :]
    slopes = jnp.exp2(-8.0 * jnp.arange(1, N_Q_HEADS + 1, dtype=f32) / N_Q_HEADS)
    slopes = slopes.reshape(N_KV_HEADS, Q_PER_KV)
    scores = scores - slopes[:, :, None, None] * dist.astype(f32)
    scores = jnp.where(valid[None, :, None, None, :, :], scores, -jnp.inf)
    sink = sinks.astype(f32).reshape(N_KV_HEADS, Q_PER_KV)[None, None, :, :, None, None]
    m = jnp.maximum(jnp.max(scores, axis=-1, keepdims=True), sink)
    pr = jnp.exp(scores - m)
    pr = pr / (jnp.sum(pr, axis=-1, keepdims=True) + jnp.exp(sink - m))
    out = jnp.einsum('bnkgts,bnskd->bntkgd', pr.astype(v.dtype), vw)
    return out.reshape(bsz, L, N_Q_HEADS * HEAD_DIM)


def setup_inputs(seed: int = 0) -> dict:
    key = jax.random.key(seed)
    ks = jax.random.split(key, 32)
    f32 = jnp.float32

    def nrm(k, shape, scale):
        return jax.random.normal(k, shape, f32) * scale

    def gain(k, shape):
        return 1.0 + 0.02 * jax.random.normal(k, shape, f32)

    lam_im0 = jnp.pi * jnp.arange(S5_STATE, dtype=f32)
    return {
        "x": jax.random.normal(ks[0], (BATCH, SEQ, D_MODEL), f32),
        "p": jax.random.normal(ks[1], (DEPTH, BATCH, SEQ, PLE_DIM), f32),
        "mix_norm": gain(ks[2], (DEPTH, D_MODEL)),
        "mlp_norm": gain(ks[3], (DEPTH, D_MODEL)),
        "ple_norm": gain(ks[4], (DEPTH, D_MODEL)),
        "final_norm": gain(ks[5], (D_MODEL,)),
        "w_in_even": nrm(ks[6], (N_EVEN, D_MODEL, EVEN_IN), D_MODEL ** -0.5),
        "w_out_even": nrm(ks[7], (N_EVEN, S5_WIDTH + HG_WIDTH, D_MODEL), (S5_WIDTH + HG_WIDTH) ** -0.5),
        "s5_lam_re": -0.5 + 0.01 * jax.random.normal(ks[8], (N_EVEN, S5_GROUPS, S5_STATE), f32),
        "s5_lam_im": lam_im0 + 0.01 * jax.random.normal(ks[9], (N_EVEN, S5_GROUPS, S5_STATE), f32),
        "s5_log_dt": jax.random.uniform(ks[10], (N_EVEN, S5_GROUPS), f32,
                                        minval=math.log(1e-3), maxval=math.log(1e-1)),
        "s5_b_re": nrm(ks[11], (N_EVEN, S5_GROUPS, S5_STATE, S5_GROUP), (2 * S5_GROUP) ** -0.5),
        "s5_b_im": nrm(ks[12], (N_EVEN, S5_GROUPS, S5_STATE, S5_GROUP), (2 * S5_GROUP) ** -0.5),
        "s5_c_re": nrm(ks[13], (N_EVEN, S5_GROUPS, S5_GROUP, S5_STATE), S5_STATE ** -0.5),
        "s5_c_im": nrm(ks[14], (N_EVEN, S5_GROUPS, S5_GROUP, S5_STATE), S5_STATE ** -0.5),
        "s5_d": nrm(ks[15], (N_EVEN, S5_GROUPS, S5_GROUP), 1.0),
        "s5_w_glu": nrm(ks[16], (N_EVEN, S5_WIDTH, S5_WIDTH), S5_WIDTH ** -0.5),
        "s5_b_glu": nrm(ks[17], (N_EVEN, S5_WIDTH), 0.01),
        "hgrn_lb_logits": nrm(ks[18], (N_EVEN, HG_WIDTH), 1.0),
        "hgrn_norm": gain(ks[19], (N_EVEN, HG_HEADS, HG_DV)),
        "w_qkv_odd": nrm(ks[20], (N_ODD, D_MODEL, ODD_IN), D_MODEL ** -0.5),
        "w_o_odd": nrm(ks[21], (N_ODD, N_Q_HEADS * HEAD_DIM, D_MODEL), (N_Q_HEADS * HEAD_DIM) ** -0.5),
        "attn_sinks": nrm(ks[22], (N_ODD, N_Q_HEADS), 0.5),
        "w_mlp_in": nrm(ks[23], (DEPTH, D_MODEL, D_FF), D_MODEL ** -0.5),
        "w_mlp_out": nrm(ks[24], (DEPTH, D_FF, D_MODEL), D_FF ** -0.5),
        "w_ple_up": nrm(ks[25], (DEPTH, PLE_DIM, D_MODEL), PLE_DIM ** -0.5),
        "w_ple_gate": nrm(ks[26], (DEPTH, D_MODEL, D_MODEL), D_MODEL ** -0.5),
    }


def reference(x, p, mix_norm, mlp_norm, ple_norm, final_norm, w_in_even, w_out_even,
              s5_lam_re, s5_lam_im, s5_log_dt, s5_b_re, s5_b_im, s5_c_re, s5_c_im, s5_d,
              s5_w_glu, s5_b_glu, hgrn_lb_logits, hgrn_norm, w_qkv_odd, w_o_odd, attn_sinks,
              w_mlp_in, w_mlp_out, w_ple_up, w_ple_gate):
    bsz, L, _ = x.shape
    lb_sm = jax.nn.softmax(hgrn_lb_logits.astype(jnp.float32), axis=0)
    lower_bounds = jnp.cumsum(lb_sm, axis=0) - lb_sm[0:1]
    h = x
    for i in range(DEPTH):
        j = i // 2
        hn = rms_norm(h, mix_norm[i])
        if i % 2 == 0:
            proj = hn @ w_in_even[j]
            u, q_b, f_b, i_b, g_b = jnp.split(
                proj, [S5_WIDTH, S5_WIDTH + HG_WIDTH, S5_WIDTH + 2 * HG_WIDTH,
                       S5_WIDTH + 3 * HG_WIDTH], axis=-1)
            y_a = s5_mixer(u, s5_lam_re[j], s5_lam_im[j], s5_log_dt[j], s5_b_re[j], s5_b_im[j],
                           s5_c_re[j], s5_c_im[j], s5_d[j], s5_w_glu[j], s5_b_glu[j])
            y_b = hgrn2_mixer(q_b, f_b, i_b, g_b, lower_bounds[j], hgrn_norm[j])
            h = h + jnp.concatenate([y_a, y_b], axis=-1) @ w_out_even[j]
        else:
            proj = hn @ w_qkv_odd[j]
            nq = N_Q_HEADS * HEAD_DIM
            nkv = N_KV_HEADS * HEAD_DIM
            q = proj[..., :nq].reshape(bsz, L, N_Q_HEADS, HEAD_DIM)
            k = proj[..., nq:nq + nkv].reshape(bsz, L, N_KV_HEADS, HEAD_DIM)
            v = proj[..., nq + nkv:].reshape(bsz, L, N_KV_HEADS, HEAD_DIM)
            h = h + swa_sink_attention(q, k, v, attn_sinks[j]) @ w_o_odd[j]
        hn = rms_norm(h, mlp_norm[i])
        h = h + jnp.square(jax.nn.relu(hn @ w_mlp_in[i])) @ w_mlp_out[i]
        hn = rms_norm(h, ple_norm[i])
        h = h + (p[i] @ w_ple_up[i]) * jax.nn.sigmoid(hn @ w_ple_gate[i])
    return rms_norm(h, final_norm)
```

```cpp
#include <hip/hip_runtime.h>
#include <hip/hip_cooperative_groups.h>
#include <cstdio>
#include <cstdint>
namespace cg = cooperative_groups;

#define LAS __attribute__((address_space(3)))
typedef unsigned short bf16_t;
typedef short bf16x8 __attribute__((ext_vector_type(8)));
typedef short s16x4 __attribute__((ext_vector_type(4)));
typedef float f32x4 __attribute__((ext_vector_type(4)));
typedef unsigned u32x4 __attribute__((ext_vector_type(4)));
typedef unsigned u32x2 __attribute__((ext_vector_type(2)));

constexpr int T_ = 32768, D_ = 1024, SEQ_ = 8192;
constexpr float EPS_ = 1e-6f;
constexpr size_t MiB = 1ull << 20;
constexpr size_t WS_WIN = 1 * MiB;
constexpr size_t WS_WOUT = 11 * MiB;
constexpr size_t WS_WGLU = 15 * MiB;
constexpr size_t WS_WQKV = 16 * MiB;
constexpr size_t WS_WO = 22 * MiB;
constexpr size_t WS_W1 = 26 * MiB;
constexpr size_t WS_W2 = 58 * MiB;
constexpr size_t WS_WUP = 90 * MiB;
constexpr size_t WS_WG = 92 * MiB;
constexpr size_t WS_BMAT = 100 * MiB;
constexpr size_t WS_EMAT = 140 * MiB;
constexpr size_t WS_A32 = 156 * MiB;
constexpr size_t WS_HB = 157 * MiB;
constexpr size_t WS_SSQ = 221 * MiB;
constexpr size_t WS_R = 223 * MiB;
constexpr size_t WS_QFIG = WS_R;
constexpr size_t WS_UCAT = WS_R + 128 * MiB;
constexpr size_t WS_LEND = WS_R + 168 * MiB;
constexpr size_t WS_ZBUF = WS_R + 184 * MiB;
constexpr size_t WS_KVT = WS_R + 216 * MiB;
constexpr size_t WS_DBUF = WS_R + 280 * MiB;
constexpr size_t WS_QKV = WS_R;
constexpr size_t WS_AOUT = WS_R + 96 * MiB;
constexpr size_t WS_HID = WS_R;
constexpr size_t WS_PB = WS_R + 256 * MiB;
constexpr size_t WS_SIG = WS_R;
constexpr size_t WS_END = WS_R + 281 * MiB;

constexpr int LDS_BYTES = 147456;
#ifndef PH
#define PH 0xFFFFFF
#endif
#define ON(n) ((PH >> (n)) & 1)

__device__ __forceinline__ int ltid() { int t = threadIdx.x; asm volatile("" : "+v"(t)); return t; }
__device__ __forceinline__ int lbid() { int b = blockIdx.x; asm volatile("" : "+s"(b)); return b; }
__device__ __forceinline__ int lgrid() { int g = gridDim.x; asm volatile("" : "+s"(g)); return g; }
__device__ __forceinline__ unsigned f2bf(float f) { unsigned u = __float_as_uint(f); return (u + 0x7fffu + ((u >> 16) & 1u)) >> 16; }
__device__ __forceinline__ float bf2f(unsigned b) { return __uint_as_float(b << 16); }
__device__ __forceinline__ float bflo(unsigned w) { return __uint_as_float(w << 16); }
__device__ __forceinline__ float bfhi(unsigned w) { return __uint_as_float(w & 0xffff0000u); }
typedef float f32x2_t __attribute__((ext_vector_type(2)));
typedef __bf16 bf16x2_t __attribute__((ext_vector_type(2)));
__device__ __forceinline__ unsigned pk2(float lo, float hi) { const f32x2_t v = {lo, hi}; const bf16x2_t b = __builtin_convertvector(v, bf16x2_t); return __builtin_bit_cast(unsigned, b); }
__device__ __forceinline__ float sigmoidf_(float x) { return 1.0f / (1.0f + __expf(-x)); }
__device__ __forceinline__ float gelu_tanh(float x) { const float u = 0.7978845608028654f * (x + 0.044715f * x * x * x); return x * sigmoidf_(2.0f * u); }
__device__ __forceinline__ float log_sigmoid_(float z) { return fminf(z, 0.f) - log1pf(__expf(-fabsf(z))); }
__device__ __forceinline__ float logaddexp_(float a, float b) { const float m = fmaxf(a, b); return m + log1pf(__expf(-fabsf(a - b))); }
__device__ __forceinline__ float row_rstd(const float* ssq, int row) {
    const f32x4* p = (const f32x4*)(ssq + (size_t)row * 16);
    const f32x4 a = p[0], b = p[1], c = p[2], d = p[3];
    const float s = (((a[0] + a[1]) + (a[2] + a[3])) + ((b[0] + b[1]) + (b[2] + b[3]))) + (((c[0] + c[1]) + (c[2] + c[3])) + ((d[0] + d[1]) + (d[2] + d[3])));
    return rsqrtf(s * (1.0f / 1024.0f) + EPS_);
}

__device__ __forceinline__ float row_rstd4(const float* ssq, unsigned row, int fq) {
    const f32x4 a = *(const f32x4*)(ssq + (row * 16u + (unsigned)fq * 4u));
    float s = (a[0] + a[1]) + (a[2] + a[3]);
    s += __shfl_xor(s, 16); s += __shfl_xor(s, 32);
    return rsqrtf(s * (1.0f / 1024.0f) + EPS_);
}

namespace pg8 {
constexpr int BM = 256, BK = 64, HALF = 128, HTB = HALF * BK * 2, STAGE_BYTES = 8 * HTB, NXCD = 8, WGM = 8;
__host__ __device__ __forceinline__ int lds_byte(int r, int c) { const int st = (r >> 4) * 2 + (c >> 5), rr = r & 15, cc = c & 31, ob = rr * 64 + cc * 2; return st * 1024 + (ob ^ (((ob >> 9) & 1) << 5)); }
__host__ __device__ __forceinline__ void stage_rc(int b, int& R, int& C) { const int st = b / 1024, sb = b % 1024, swz = sb ^ (((sb >> 9) & 1) << 5); R = (st >> 1) * 16 + swz / 64; C = (st & 1) * 32 + (swz % 64) / 2; }
__host__ __device__ __forceinline__ int perm32(int rho) { const int n = rho >> 4, i = rho & 15; return 8 * (i >> 2) + 4 * n + (i & 3); }

struct Unit { int pm, pn; };
struct Gemm { const bf16_t* A; const bf16_t* Bt; int M, N, K, lda, ldb, mtpg; };

struct StaticOrder {
    int nM, nN, nwg, G, c;
    __device__ void init(int M, int N, int G_, int c_) { nM = M / BM; nN = N / BM; nwg = nM * nN; G = G_; c = c_; }
    __device__ bool next(int i, Unit& u) const {
        const long L = (long)i * G + c; if (L >= nwg) return false;
        int wgid = (int)L; { const int q = nwg / NXCD, r = nwg % NXCD, xcd = wgid % NXCD, off = wgid / NXCD; wgid = (xcd < r ? xcd * (q + 1) : r * (q + 1) + (xcd - r) * q) + off; }
        const int nig = WGM * nN, gid = wgid / nig, fm = gid * WGM, gsz = (nM - fm) < WGM ? (nM - fm) : WGM;
        u.pm = fm + ((wgid % nig) % gsz); u.pn = (wgid % nig) / gsz; return true;
    }
};

struct EpiP {
    const float* ssq_in; float* ssq_out; const float* hin; float* hout; bf16_t* hb;
    bf16_t* o1; bf16_t* o2; const bf16_t* aux; const float* bias; float* fout;
};

template <int MODE> struct Epi {
    static constexpr bool PERM = (MODE <= 5);
    EpiP p;
    static constexpr bool RSTD = (MODE <= 3);
    __device__ __forceinline__ void operator()(const f32x4 (&acc)[2][2][4][2], const Unit& u, int wr, int wc, int fr_, int fq_, bool use_tab, const LAS float* rt) const {
        int fr = fr_, fq = fq_;
        asm volatile("" : "+v"(fr), "+v"(fq));
        const int row0 = u.pm * BM + wr * 64 + fr;
        if constexpr (MODE <= 5) {
            const int colt = u.pn * BM + wc * 32 + 8 * fq;
            float rsv[2][4];
            u32x4 zall[2][4][2];
            if constexpr (MODE == 5) {
#pragma unroll
                for (int ai = 0; ai < 2; ++ai)
#pragma unroll
                    for (int m = 0; m < 4; ++m) { const unsigned zo = (unsigned)((row0 + ai * HALF + m * 16) * 512 + colt);
                        zall[ai][m][0] = *(const u32x4*)(p.aux + zo); zall[ai][m][1] = *(const u32x4*)(p.aux + zo + HALF); }
            }
#pragma unroll
            for (int ai = 0; ai < 2; ++ai)
#pragma unroll
                for (int m = 0; m < 4; ++m) {
                    rsv[ai][m] = 1.0f;
                }
            if constexpr (MODE <= 3) {
              if (use_tab) {
#pragma unroll
                for (int ai = 0; ai < 2; ++ai)
#pragma unroll
                    for (int m = 0; m < 4; ++m) rsv[ai][m] = rt[wr * 64 + fr + ai * HALF + m * 16];
              } else {
                f32x4 pv[2][4];
#pragma unroll
                for (int ai = 0; ai < 2; ++ai)
#pragma unroll
                    for (int m = 0; m < 4; ++m) pv[ai][m] = *(const f32x4*)(p.ssq_in + ((unsigned)(row0 + ai * HALF + m * 16) * 16u + (unsigned)fq * 4u));
#pragma unroll
                for (int ai = 0; ai < 2; ++ai)
#pragma unroll
                    for (int m = 0; m < 4; ++m) { float sx = (pv[ai][m][0] + pv[ai][m][1]) + (pv[ai][m][2] + pv[ai][m][3]); sx += __shfl_xor(sx, 16); sx += __shfl_xor(sx, 32); rsv[ai][m] = rsqrtf(sx * (1.0f / 1024.0f) + EPS_); }
              }
            }
#pragma unroll
            for (int ai = 0; ai < 2; ++ai)
#pragma unroll
                for (int m = 0; m < 4; ++m) {
                    const int row = row0 + ai * HALF + m * 16;
                    float rs = rsv[ai][m];
                    if constexpr (MODE == 1) { if (u.pn < 4) rs *= 0.125f; }
                    u32x4 zpre[2];
                    if constexpr (MODE == 5) { zpre[0] = zall[ai][m][0]; zpre[1] = zall[ai][m][1]; }
#pragma unroll
                    for (int bj = 0; bj < 2; ++bj) {
                        const int col = colt + bj * HALF;
                        f32x4 v0 = acc[ai][bj][m][0] * rs, v1 = acc[ai][bj][m][1] * rs;
                        bf16_t* dest;
                        if constexpr (MODE == 0) {
                            if (u.pn < 2) dest = p.o2 + (unsigned)(((col >> 4) * 1024 + (row >> 5)) * 640 + (row & 31) * 16 + (col & 15));
                            else dest = p.o1 + (unsigned)(row * 2048 + (col - 512));
                        } else if constexpr (MODE == 1) {
                            dest = p.o1 + (unsigned)(row * 1536 + col);
                        } else if constexpr (MODE == 2) {
#pragma unroll
                            for (int e = 0; e < 4; ++e) { float a = fmaxf(v0[e], 0.f), b = fmaxf(v1[e], 0.f); v0[e] = a * a; v1[e] = b * b; }
                            dest = p.o1 + (unsigned)(row * 4096 + col);
                        } else if constexpr (MODE == 3) {
#pragma unroll
                            for (int e = 0; e < 4; ++e) { v0[e] = sigmoidf_(v0[e]); v1[e] = sigmoidf_(v1[e]); }
                            dest = p.o1 + (unsigned)(row * 1024 + col);
                        } else if constexpr (MODE == 4) {
#pragma unroll
                            for (int e = 0; e < 4; ++e) { v0[e] = gelu_tanh(v0[e]); v1[e] = gelu_tanh(v1[e]); }
                            const int g = row >> 10, bc = row & 1023, tok = bc * 32 + (col >> 4);
                            dest = p.o1 + (unsigned)(tok * 512 + g * 16 + (col & 15));
                        } else {
                            const u32x4 z = zpre[bj];
                            const f32x4 b0 = *(const f32x4*)(p.bias + col), b1 = *(const f32x4*)(p.bias + col + 4);
                            v0[0] = bflo(z.x) * sigmoidf_(v0[0] + b0[0]); v0[1] = bfhi(z.x) * sigmoidf_(v0[1] + b0[1]);
                            v0[2] = bflo(z.y) * sigmoidf_(v0[2] + b0[2]); v0[3] = bfhi(z.y) * sigmoidf_(v0[3] + b0[3]);
                            v1[0] = bflo(z.z) * sigmoidf_(v1[0] + b1[0]); v1[1] = bfhi(z.z) * sigmoidf_(v1[1] + b1[1]);
                            v1[2] = bflo(z.w) * sigmoidf_(v1[2] + b1[2]); v1[3] = bfhi(z.w) * sigmoidf_(v1[3] + b1[3]);
                            dest = p.o1 + (unsigned)(row * 2048 + 1024 + col);
                        }
                        u32x4 w; w.x = pk2(v0[0], v0[1]); w.y = pk2(v0[2], v0[3]); w.z = pk2(v1[0], v1[1]); w.w = pk2(v1[2], v1[3]);
                        *(u32x4*)dest = w;
                    }
                    if (m & 1) asm volatile("" ::: "memory");
                }
        } else if constexpr (MODE == 6 || MODE == 7) {
            const int col0 = u.pn * BM + wc * 32 + 4 * fq;
#pragma unroll
            for (int ai = 0; ai < 2; ++ai)
#pragma unroll
                for (int m = 0; m < 4; ++m) {
                    const int row = row0 + ai * HALF + m * 16;
                    float ss = 0.f;
                    f32x4 hv[2][2]; u32x2 sgv[2][2];
#pragma unroll
                    for (int bj = 0; bj < 2; ++bj)
#pragma unroll
                        for (int n = 0; n < 2; ++n) {
                            const unsigned off = (unsigned)(row * 1024 + col0 + bj * HALF + n * 16);
                            if (p.hin) hv[bj][n] = *(const f32x4*)(p.hin + off);
                            else { const u32x2 hw = *(const u32x2*)(p.hb + off); hv[bj][n][0] = bflo(hw.x); hv[bj][n][1] = bfhi(hw.x); hv[bj][n][2] = bflo(hw.y); hv[bj][n][3] = bfhi(hw.y); }
                            if constexpr (MODE == 7) sgv[bj][n] = *(const u32x2*)(p.aux + off);
                        }
#pragma unroll
                    for (int bj = 0; bj < 2; ++bj)
#pragma unroll
                        for (int n = 0; n < 2; ++n) {
                            const unsigned off = (unsigned)(row * 1024 + col0 + bj * HALF + n * 16);
                            f32x4 a = acc[ai][bj][m][n];
                            if constexpr (MODE == 7) { const u32x2 sg = sgv[bj][n]; a[0] *= bflo(sg.x); a[1] *= bfhi(sg.x); a[2] *= bflo(sg.y); a[3] *= bfhi(sg.y); }
                            const f32x4 v = hv[bj][n] + a;
                            u32x2 w; w.x = pk2(v[0], v[1]); w.y = pk2(v[2], v[3]);
                            *(u32x2*)(p.hb + off) = w;
                            ss += (v[0] * v[0] + v[1] * v[1]) + (v[2] * v[2] + v[3] * v[3]);
                        }
                    ss += __shfl_xor(ss, 16); ss += __shfl_xor(ss, 32);
                    if (fq == 0) p.ssq_out[(unsigned)(row * 16 + u.pn * 4 + wc)] = ss;
                    if (m & 1) asm volatile("" ::: "memory");
                }
        } else {
            const int col0 = wc * 32 + 4 * fq;
#pragma unroll
            for (int ai = 0; ai < 2; ++ai)
#pragma unroll
                for (int m = 0; m < 4; ++m) {
                    const int row = row0 + ai * HALF + m * 16;
#pragma unroll
                    for (int n = 0; n < 2; ++n) *(f32x4*)(p.fout + (unsigned)(row * 128 + col0 + n * 16)) = acc[ai][0][m][n];
                }
        }
    }
};

template <class EpiT>
__device__ __forceinline__ void gemm_phase(LAS unsigned char* lds, const Gemm g, const StaticOrder& S, const EpiT& E) {
    const int tid = ltid(), wid = __builtin_amdgcn_readfirstlane(tid >> 6), lane = tid & 63, wr = wid >> 2, wc = wid & 3, fr = lane & 15, fq = lane >> 4;
    const int K = g.K, nt = K / BK;
    unsigned voffA[2], voffB[2];
#pragma unroll
    for (int i = 0; i < 2; ++i) { int R, C; stage_rc(tid * 16 + i * 8192, R, C); const int Rb = EpiT::PERM ? ((R & ~31) + perm32(R & 31)) : R;
        voffA[i] = (unsigned)(R * g.lda + C) * 2u; voffB[i] = (unsigned)(Rb * g.ldb + C) * 2u; }
    constexpr unsigned kstep = BK * 2;
    const unsigned hstepA = (unsigned)(HALF * g.lda * 2), hstepB = (unsigned)(HALF * g.ldb * 2);
    const unsigned tstepA = 2 * hstepA, tstepB = 2 * hstepB;
    const int nNt = g.N / BM;
    const unsigned ldsw = (unsigned)wid * 1024u;
    const int aoff = lds_byte(wr * 64 + fr, fq * 8), boff = lds_byte(wc * 32 + fr, fq * 8);
#define PG8_SA(b, h) (((b) * 2 + (h)) * HTB)
#define PG8_SB(b, h) ((4 + (b) * 2 + (h)) * HTB)
#define PG8_STAGE(bufoff, gbase, voff) do { _Pragma("unroll") for (int _i = 0; _i < 2; ++_i) \
        __builtin_amdgcn_global_load_lds((const unsigned*)((const char*)(gbase) + (voff)[_i]), (LAS unsigned*)(lds + (bufoff) + ldsw + _i * 8192), 16, 0, 0); } while (0)
#define PG8_LDA(dst, b, h) do { _Pragma("unroll") for (int m = 0; m < 4; ++m) _Pragma("unroll") for (int k = 0; k < 2; ++k) dst[m][k] = *(const LAS bf16x8*)(lds + PG8_SA(b, h) + aoff + m * 2048 + k * 1024); } while (0)
#define PG8_LDB(dst, b, h) do { _Pragma("unroll") for (int n = 0; n < 2; ++n) _Pragma("unroll") for (int k = 0; k < 2; ++k) dst[n][k] = *(const LAS bf16x8*)(lds + PG8_SB(b, h) + boff + n * 2048 + k * 1024); } while (0)
#define PG8_MMA(ai, bj, At, Bt) do { __builtin_amdgcn_s_setprio(1); _Pragma("unroll") for (int m = 0; m < 4; ++m) _Pragma("unroll") for (int n = 0; n < 2; ++n) _Pragma("unroll") for (int k = 0; k < 2; ++k) \
        acc[ai][bj][m][n] = __builtin_amdgcn_mfma_f32_16x16x32_bf16(Bt[n][k], At[m][k], acc[ai][bj][m][n], 0, 0, 0); __builtin_amdgcn_s_setprio(0); } while (0)
#define PG8_WAIT_V(n) asm volatile("s_waitcnt vmcnt(" #n ")" ::: "memory")
#define PG8_WAIT_L(n) asm volatile("s_waitcnt lgkmcnt(" #n ")" ::: "memory")
#define PG8_BAR __builtin_amdgcn_s_barrier()
#define PG8_SCHED __builtin_amdgcn_sched_barrier(0)
#define PG8_BBASE(u) ((const char*)g.Bt + (size_t)(((u).pm / g.mtpg) * nNt + (u).pn) * tstepB)
    Unit cur, nxt; int ui = 0;
    if (!S.next(0, cur)) return;
    LAS float* rtab = (LAS float*)(lds + STAGE_BYTES + 2048);
    bool use_tab = false; int nun = 0;
    const int rr = tid & 255, ih = __builtin_amdgcn_readfirstlane(tid >> 8);
    f32x4 pv[4][4];
    if constexpr (EpiT::RSTD) {
        { Unit uu; while (nun <= 8 && S.next(nun, uu)) ++nun; }
        use_tab = (nun <= 8);
        if (use_tab) {
#pragma unroll
            for (int ps = 0; ps < 4; ++ps) { const int i = 2 * ps + ih; Unit uu; if (i < nun && S.next(i, uu)) { const f32x4* sp = (const f32x4*)(E.p.ssq_in + (size_t)(uu.pm * BM + rr) * 16);
#pragma unroll
                for (int q = 0; q < 4; ++q) pv[ps][q] = sp[q]; } }
        }
    }
    f32x4 acc[2][2][4][2];
#pragma unroll
    for (int a = 0; a < 2; ++a)
#pragma unroll
        for (int b = 0; b < 2; ++b)
#pragma unroll
            for (int m = 0; m < 4; ++m)
#pragma unroll
                for (int n = 0; n < 2; ++n) acc[a][b][m][n] = (f32x4){0.f, 0.f, 0.f, 0.f};
    bf16x8 At[4][2], B0[2][2], B1[2][2];
    const char* cA = (const char*)g.A + (size_t)cur.pm * tstepA; const char* cB = PG8_BBASE(cur);
    PG8_STAGE(PG8_SB(0, 0), cB, voffB); PG8_STAGE(PG8_SB(0, 1), cB + hstepB, voffB); PG8_STAGE(PG8_SA(0, 0), cA, voffA); PG8_STAGE(PG8_SA(0, 1), cA + hstepA, voffA);
    if constexpr (EpiT::RSTD) {
        if (use_tab) {
#pragma unroll
            for (int ps = 0; ps < 4; ++ps) { const int i = 2 * ps + ih; if (i < nun) {
                const float sx = (((pv[ps][0][0] + pv[ps][0][1]) + (pv[ps][0][2] + pv[ps][0][3])) + ((pv[ps][1][0] + pv[ps][1][1]) + (pv[ps][1][2] + pv[ps][1][3])))
                               + (((pv[ps][2][0] + pv[ps][2][1]) + (pv[ps][2][2] + pv[ps][2][3])) + ((pv[ps][3][0] + pv[ps][3][1]) + (pv[ps][3][2] + pv[ps][3][3])));
                rtab[i * 256 + rr] = rsqrtf(sx * (1.0f / 1024.0f) + EPS_); } }
            asm volatile("s_waitcnt lgkmcnt(0)" ::: "memory");
        }
    }
    if (wr == 1) PG8_BAR;
    PG8_WAIT_V(2); PG8_BAR;
    PG8_STAGE(PG8_SB(1, 0), cB + kstep, voffB); PG8_STAGE(PG8_SA(1, 0), cA + kstep, voffA); PG8_STAGE(PG8_SB(1, 1), cB + hstepB + kstep, voffB);
    PG8_WAIT_V(6); PG8_BAR;
    for (;;) {
        const bool has_next = S.next(ui + 1, nxt);
        const char* nA = has_next ? (const char*)g.A + (size_t)nxt.pm * tstepA : cA; const char* nB = has_next ? PG8_BBASE(nxt) : cB;
        for (int t = 0; t < nt; t += 2) {
            const bool last = (t == nt - 2);
            const char* a1 = cA + (size_t)(t + 1) * kstep;
            const char* a2 = last ? nA : cA + (size_t)(t + 2) * kstep; const char* b2 = last ? nB : cB + (size_t)(t + 2) * kstep;
            const char* a3 = a2 + kstep; const char* b3 = b2 + kstep;
            PG8_LDB(B0, 0, 0); PG8_LDB(B1, 0, 1); PG8_SCHED; PG8_LDA(At, 0, 0); PG8_STAGE(PG8_SA(1, 1), a1 + hstepA, voffA);
            PG8_WAIT_V(8); PG8_WAIT_L(0); PG8_BAR; PG8_MMA(0, 0, At, B0); PG8_MMA(0, 1, At, B1); PG8_BAR; PG8_SCHED;
            PG8_LDA(At, 0, 1); PG8_STAGE(PG8_SB(0, 0), b2, voffB); PG8_STAGE(PG8_SB(0, 1), b2 + hstepB, voffB); PG8_STAGE(PG8_SA(0, 0), a2, voffA);
            PG8_WAIT_V(8); PG8_WAIT_L(0); PG8_BAR; PG8_MMA(1, 0, At, B0); PG8_MMA(1, 1, At, B1); PG8_BAR; PG8_SCHED;
            PG8_LDB(B0, 1, 0); PG8_LDB(B1, 1, 1); PG8_SCHED; PG8_LDA(At, 1, 0); PG8_STAGE(PG8_SA(0, 1), a2 + hstepA, voffA);
            PG8_WAIT_V(8); PG8_WAIT_L(0); PG8_BAR; PG8_MMA(0, 0, At, B0); PG8_MMA(0, 1, At, B1); PG8_BAR; PG8_SCHED;
            PG8_LDA(At, 1, 1); PG8_STAGE(PG8_SB(1, 0), b3, voffB); PG8_STAGE(PG8_SB(1, 1), b3 + hstepB, voffB); PG8_STAGE(PG8_SA(1, 0), a3, voffA);
            PG8_WAIT_V(8); PG8_WAIT_L(0); PG8_BAR; PG8_MMA(1, 0, At, B0); PG8_MMA(1, 1, At, B1); PG8_BAR; PG8_SCHED;
        }
        if (wr == 0) PG8_BAR;
        E(acc, cur, wr, wc, fr, fq, use_tab, rtab + ui * 256);
        if (!has_next) break;
#pragma unroll
        for (int a = 0; a < 2; ++a)
#pragma unroll
            for (int b = 0; b < 2; ++b)
#pragma unroll
                for (int m = 0; m < 4; ++m)
#pragma unroll
                    for (int n = 0; n < 2; ++n) acc[a][b][m][n] = (f32x4){0.f, 0.f, 0.f, 0.f};
        cur = nxt; cA = nA; cB = nB; ++ui;
        if (wr == 1) PG8_BAR;
    }
    PG8_WAIT_V(0);
    PG8_BAR;
#undef PG8_SA
#undef PG8_SB
#undef PG8_STAGE
#undef PG8_LDA
#undef PG8_LDB
#undef PG8_MMA
#undef PG8_WAIT_V
#undef PG8_WAIT_L
#undef PG8_BAR
#undef PG8_SCHED
#undef PG8_BBASE
}
}

struct Args { const float* in[27]; float* out; unsigned char* ws; };
typedef const __attribute__((address_space(4))) Args* ArgP;
__device__ __forceinline__ ArgP get_args() { auto p = __builtin_amdgcn_kernarg_segment_ptr(); asm volatile("" : "+s"(p)); return (ArgP)p; }
enum { I_X = 0, I_P, I_MIXN, I_MLPN, I_PLEN, I_FINN, I_WIN, I_WOUT, I_LRE, I_LIM, I_LDT, I_BRE, I_BIM, I_CRE, I_CIM, I_SD, I_WGLU, I_BGLU,
       I_LBL, I_HGN, I_WQKV, I_WO, I_SINK, I_W1, I_W2, I_WUP, I_WG };

__device__ __forceinline__ void transpose_item(const float* W, int K, int N, bf16_t* WT, const float* gain, LAS float* scr, int item, int lane) {
    const int nblk = N / 32, kb = item / nblk, nb = item % nblk, k0 = 64 * kb, n0 = 32 * nb;
    float wv[32];
#pragma unroll
    for (int i = 0; i < 32; ++i) wv[i] = W[(size_t)(k0 + 2 * i + (lane >> 5)) * N + n0 + (lane & 31)];
    if (gain) {
        float gv[32];
#pragma unroll
        for (int i = 0; i < 32; ++i) gv[i] = gain[k0 + 2 * i + (lane >> 5)];
#pragma unroll
        for (int i = 0; i < 32; ++i) wv[i] *= gv[i];
    }
#pragma unroll
    for (int i = 0; i < 32; ++i) scr[(2 * i + (lane >> 5)) * 33 + (lane & 31)] = wv[i];
    asm volatile("s_waitcnt lgkmcnt(0)" ::: "memory");
    const int c = lane & 7;
#pragma unroll
    for (int j = 0; j < 4; ++j) { const int n = (lane >> 3) + 8 * j; const LAS float* s = scr + (8 * c) * 33 + n;
        u32x4 o; o.x = pk2(s[0 * 33], s[1 * 33]); o.y = pk2(s[2 * 33], s[3 * 33]); o.z = pk2(s[4 * 33], s[5 * 33]); o.w = pk2(s[6 * 33], s[7 * 33]);
        *(u32x4*)(WT + (size_t)(n0 + n) * K + k0 + 8 * c) = o; }
    asm volatile("s_waitcnt lgkmcnt(0)" ::: "memory");
}

__device__ __forceinline__ void transpose_matrix(const float* W, int K, int N, bf16_t* WT, const float* gain, LAS float* scr, int gw, int ngw, int lane) {
    const int items = (K / 64) * (N / 32);
    for (int it = gw; it < items; it += ngw) transpose_item(W, K, N, WT, gain, scr, it, lane);
}

__device__ __forceinline__ void s5_tables(LAS unsigned char* lds, ArgP a, int j, int g, int qt) {
    LAS float* Wr = (LAS float*)lds;
    LAS float* Wi = Wr + 33 * 64;
    LAS float* Bbr = Wi + 33 * 64;
    LAS float* Bbi = Bbr + 1024;
    LAS float* Cr = Bbi + 1024;
    LAS float* Ci = Cr + 1024;
    LAS float* Kt = Ci + 1024;
    const int tid = ltid();
    const int jg = j * 32 + g;
    const float dt = expf(a->in[I_LDT][jg]);
    for (int it = tid; it < 33 * 64; it += 512) {
        const int tau = it >> 6, p = it & 63;
        const float lr = fminf(a->in[I_LRE][jg * 64 + p], -1e-4f), li = a->in[I_LIM][jg * 64 + p];
        const float mag = expf(lr * dt * (float)tau); float sn, cs; sincosf(li * dt * (float)tau, &sn, &cs);
        Wr[it] = mag * cs; Wi[it] = mag * sn;
    }
    for (int it = tid; it < 1024; it += 512) { Cr[it] = a->in[I_CRE][(size_t)jg * 1024 + it]; Ci[it] = a->in[I_CIM][(size_t)jg * 1024 + it]; }
    __syncthreads();
    for (int it = tid; it < 1024; it += 512) {
        const int p = it >> 4;
        const float lr = fminf(a->in[I_LRE][jg * 64 + p], -1e-4f), li = a->in[I_LIM][jg * 64 + p];
        const float ar = Wr[64 + p], ai = Wi[64 + p];
        const float den = lr * lr + li * li, xr = ar - 1.0f;
        const float zr = (xr * lr + ai * li) / den, zi = (ai * lr - xr * li) / den;
        const float br = a->in[I_BRE][(size_t)jg * 1024 + it], bi = a->in[I_BIM][(size_t)jg * 1024 + it];
        Bbr[it] = zr * br - zi * bi; Bbi[it] = zr * bi + zi * br;
    }
    __syncthreads();
    {
        const int pair = tid & 255, half = tid >> 8, h = pair >> 4, hp = pair & 15;
        const int nh = 4 * (qt + 1), tau0 = half * nh;
        float ka[16];
#pragma unroll
        for (int tt = 0; tt < 16; ++tt) ka[tt] = 0.f;
        for (int p = 0; p < 64; ++p) {
            const float cr = Cr[h * 64 + p], ci = Ci[h * 64 + p], br = Bbr[p * 16 + hp], bi = Bbi[p * 16 + hp];
            const float cbr = cr * br - ci * bi, cbi = cr * bi + ci * br;
#pragma unroll
            for (int tt = 0; tt < 16; ++tt) if (tt < nh) ka[tt] += cbr * Wr[(tau0 + tt) * 64 + p] - cbi * Wi[(tau0 + tt) * 64 + p];
        }
#pragma unroll
        for (int tt = 0; tt < 16; ++tt) if (tt < nh) {
            const int tau = tau0 + tt; float v = ka[tt];
            if (tau == 0 && h == hp) v += a->in[I_SD][jg * 16 + h];
            Kt[(tau * 16 + h) * 16 + hp] = v;
        }
    }
    __syncthreads();
    bf16_t* Bmat = (bf16_t*)(a->ws + WS_BMAT) + (size_t)jg * 512 * 640;
    for (int ch = tid; ch < 128 * 80; ch += 512) {
        const int row = qt * 128 + ch / 80, c8 = ch % 80, t = row >> 4, h = row & 15;
        float v[8];
        if (c8 < 64) {
            const int jj = c8 >> 1, h0 = (c8 & 1) * 8, tau = t - jj;
#pragma unroll
            for (int e = 0; e < 8; ++e) v[e] = (tau >= 0) ? Kt[(tau * 16 + h) * 16 + h0 + e] : 0.f;
        } else {
            const int im = (c8 >= 72), p0 = (c8 - (im ? 72 : 64)) * 8;
#pragma unroll
            for (int e = 0; e < 8; ++e) { const int p = p0 + e; const float cr = Cr[h * 64 + p], ci = Ci[h * 64 + p], wr = Wr[(t + 1) * 64 + p], wi = Wi[(t + 1) * 64 + p];
                v[e] = im ? -(cr * wi + ci * wr) : (cr * wr - ci * wi); }
        }
        u32x4 o; o.x = pk2(v[0], v[1]); o.y = pk2(v[2], v[3]); o.z = pk2(v[4], v[5]); o.w = pk2(v[6], v[7]);
        *(u32x4*)(Bmat + (size_t)row * 640 + c8 * 8) = o;
    }
    bf16_t* Emat = (bf16_t*)(a->ws + WS_EMAT) + (size_t)jg * 256 * 512;
    for (int ch = tid; ch < 64 * 64; ch += 512) {
        const int pr = qt * 64 + (ch >> 6), c8 = ch & 63, jj = c8 >> 1, h0 = (c8 & 1) * 8;
        float v[8];
        if (pr < 128) {
            const int p = pr & 63, im = pr >> 6; const float wr = Wr[(31 - jj) * 64 + p], wi = Wi[(31 - jj) * 64 + p];
#pragma unroll
            for (int e = 0; e < 8; ++e) { const float br = Bbr[p * 16 + h0 + e], bi = Bbi[p * 16 + h0 + e]; v[e] = im ? (wr * bi + wi * br) : (wr * br - wi * bi); }
        } else {
#pragma unroll
            for (int e = 0; e < 8; ++e) v[e] = 0.f;
        }
        u32x4 o; o.x = pk2(v[0], v[1]); o.y = pk2(v[2], v[3]); o.z = pk2(v[4], v[5]); o.w = pk2(v[6], v[7]);
        *(u32x4*)(Emat + (size_t)pr * 512 + c8 * 8) = o;
    }
    float* A32 = (float*)(a->ws + WS_A32) + (size_t)jg * 128;
    if (qt == 0 && tid < 64) { A32[tid * 2] = Wr[32 * 64 + tid]; A32[tid * 2 + 1] = Wi[32 * 64 + tid]; }
    __syncthreads();
}

__device__ __forceinline__ float wave_sum(float v) {
#pragma unroll
    for (int o = 1; o < 64; o <<= 1) v += __shfl_xor(v, o);
    return v;
}

__device__ __forceinline__ float hg_lb(ArgP a, int j, int ch) {
    if (j == 0) return 0.f;
    const float l0 = a->in[I_LBL][ch], l1 = a->in[I_LBL][512 + ch];
    return 1.0f / (1.0f + expf(l0 - l1));
}
__device__ __forceinline__ void hg_gate(float z, float lbm, float oml, float& lf, float& kval) {
    const float zc = fminf(fmaxf(z, -30.f), 30.f);
    const float e = __expf(-zc), r = __builtin_amdgcn_rcpf(1.0f + e);
    lf = __logf(lbm + oml * r); kval = oml * (e * r);
}

__device__ __forceinline__ void hg_pass1(LAS unsigned char* lds, ArgP a, int j, int unit) {
    LAS float* segs = (LAS float*)lds;
    LAS bf16_t* Kh = (LAS bf16_t*)(lds + 2048);
    LAS bf16_t* Vt = (LAS bf16_t*)(lds + 2048 + 18432);
    const bf16_t* qfig = (const bf16_t*)(a->ws + WS_QFIG);
    bf16_t* kvt = (bf16_t*)(a->ws + WS_KVT) + (size_t)unit * 16384;
    float* dbuf = (float*)(a->ws + WS_DBUF) + (size_t)unit * 128;
    const int tid = ltid(), lane = tid & 63, w = tid >> 6, fr = lane & 15, quad = lane >> 4;
    const int b = unit >> 9, hh = (unit >> 7) & 3, c = unit & 127;
    const int tok0 = b * SEQ_ + c * 64;
    const int k = tid & 127, seg = tid >> 7;
    unsigned zr[16];
    const bf16_t* zp = qfig + (size_t)(tok0 + seg * 16) * 2048 + 512 + hh * 128 + k;
#pragma unroll
    for (int tt = 0; tt < 16; ++tt) zr[tt] = zp[(size_t)tt * 2048];
    u32x4 vv[2];
#pragma unroll
    for (int i = 0; i < 2; ++i) { const int idx = tid + 512 * i; vv[i] = *(const u32x4*)(qfig + (size_t)(tok0 + (idx & 63)) * 2048 + 1024 + hh * 128 + (idx >> 6) * 8); }
    const float lb = hg_lb(a, j, hh * 128 + k);
    const float lbm = fmaxf(lb, 1e-30f), oml = 1.0f - lb;
    float run[16], kval[16]; float acc_ = 0.f;
#pragma unroll
    for (int tt = 0; tt < 16; ++tt) { float lf; hg_gate(bf2f(zr[tt]), lbm, oml, lf, kval[tt]); acc_ += lf; run[tt] = acc_; }
    segs[seg * 128 + k] = acc_;
#pragma unroll
    for (int i = 0; i < 2; ++i) {
        const int idx = tid + 512 * i, t = idx & 63, v0 = (idx >> 6) * 8;
        Vt[(v0 + 0) * 72 + t] = (bf16_t)(vv[i].x & 0xffff); Vt[(v0 + 1) * 72 + t] = (bf16_t)(vv[i].x >> 16);
        Vt[(v0 + 2) * 72 + t] = (bf16_t)(vv[i].y & 0xffff); Vt[(v0 + 3) * 72 + t] = (bf16_t)(vv[i].y >> 16);
        Vt[(v0 + 4) * 72 + t] = (bf16_t)(vv[i].z & 0xffff); Vt[(v0 + 5) * 72 + t] = (bf16_t)(vv[i].z >> 16);
        Vt[(v0 + 6) * 72 + t] = (bf16_t)(vv[i].w & 0xffff); Vt[(v0 + 7) * 72 + t] = (bf16_t)(vv[i].w >> 16);
    }
    __syncthreads();
    float off = 0.f, total = 0.f;
#pragma unroll
    for (int s4 = 0; s4 < 4; ++s4) { const float x = segs[s4 * 128 + k]; total += x; if (s4 < seg) off += x; }
    const float rem = total - off;
#pragma unroll
    for (int tt = 0; tt < 16; tt += 4) {
        u32x2 o; o.x = pk2(kval[tt] * __expf(rem - run[tt]), kval[tt + 1] * __expf(rem - run[tt + 1]));
        o.y = pk2(kval[tt + 2] * __expf(rem - run[tt + 2]), kval[tt + 3] * __expf(rem - run[tt + 3]));
        *(LAS u32x2*)(Kh + k * 72 + seg * 16 + tt) = o;
    }
    if (seg == 0) dbuf[k] = __expf(total);
    __syncthreads();
    bf16x8 vf[2];
#pragma unroll
    for (int ks = 0; ks < 2; ++ks) vf[ks] = *(const LAS bf16x8*)(Vt + (w * 16 + fr) * 72 + ks * 32 + quad * 8);
#pragma unroll
    for (int kt = 0; kt < 8; ++kt) {
        f32x4 acc = (f32x4){0.f, 0.f, 0.f, 0.f};
#pragma unroll
        for (int ks = 0; ks < 2; ++ks) {
            const bf16x8 kf = *(const LAS bf16x8*)(Kh + (kt * 16 + fr) * 72 + ks * 32 + quad * 8);
            acc = __builtin_amdgcn_mfma_f32_16x16x32_bf16(kf, vf[ks], acc, 0, 0, 0);
        }
        u32x2 o; o.x = pk2(acc[0], acc[1]); o.y = pk2(acc[2], acc[3]);
        *(u32x2*)(kvt + (size_t)(w * 16 + fr) * 128 + kt * 16 + quad * 4) = o;
    }
    __syncthreads();
}

__device__ __forceinline__ void hg_pass3(LAS unsigned char* lds, ArgP a, int j, int unit) {
    LAS float* segs = (LAS float*)lds;
    LAS float* red = segs + 512;
    LAS bf16_t* Qi = (LAS bf16_t*)(lds + 4096);
    LAS bf16_t* Qa = (LAS bf16_t*)(lds + 4096 + 17408);
    LAS bf16_t* Ka = (LAS bf16_t*)(lds + 4096 + 2 * 17408);
    LAS bf16_t* Vt = (LAS bf16_t*)(lds + 4096 + 3 * 17408);
    bf16_t* qfig = (bf16_t*)(a->ws + WS_QFIG);
    const bf16_t* St = (const bf16_t*)(a->ws + WS_KVT) + (size_t)unit * 16384;
    const int tid = ltid(), lane = tid & 63, w = tid >> 6, fr = lane & 15, quad = lane >> 4;
    const int b = unit >> 9, hh = (unit >> 7) & 3, c = unit & 127;
    const int tok0 = b * SEQ_ + c * 64;
    const int k = tid & 127, seg = tid >> 7;
    const int mt = w & 3, vh = w >> 2;
    unsigned zr[16], qr[16];
    const bf16_t* zp = qfig + (size_t)(tok0 + seg * 16) * 2048 + hh * 128 + k;
#pragma unroll
    for (int tt = 0; tt < 16; ++tt) { zr[tt] = zp[(size_t)tt * 2048 + 512]; qr[tt] = zp[(size_t)tt * 2048]; }
    u32x4 vv[2];
#pragma unroll
    for (int i = 0; i < 2; ++i) { const int idx = tid + 512 * i; vv[i] = *(const u32x4*)(qfig + (size_t)(tok0 + (idx & 63)) * 2048 + 1024 + hh * 128 + (idx >> 6) * 8); }
    bf16x8 sf[4][4];
#pragma unroll
    for (int ks = 0; ks < 4; ++ks)
#pragma unroll
        for (int n = 0; n < 4; ++n) sf[ks][n] = *(const bf16x8*)(St + (size_t)(vh * 64 + n * 16 + fr) * 128 + ks * 32 + quad * 8);
    unsigned gr[4][4];
    bf16_t* gp = qfig + (size_t)(tok0 + mt * 16 + quad * 4) * 2048 + 1536 + hh * 128 + vh * 64 + fr;
#pragma unroll
    for (int e = 0; e < 4; ++e)
#pragma unroll
        for (int n = 0; n < 4; ++n) gr[e][n] = gp[(size_t)e * 2048 + n * 16];
    const float lb = hg_lb(a, j, hh * 128 + k);
    const float lbm = fmaxf(lb, 1e-30f), oml = 1.0f - lb;
    float run[16], kval[16]; float acc_ = 0.f;
#pragma unroll
    for (int tt = 0; tt < 16; ++tt) { float lf; hg_gate(bf2f(zr[tt]), lbm, oml, lf, kval[tt]); acc_ += lf; run[tt] = acc_; }
    segs[seg * 128 + k] = acc_;
#pragma unroll
    for (int i = 0; i < 2; ++i) {
        const int idx = tid + 512 * i, t = idx & 63, v0 = (idx >> 6) * 8;
        Vt[(v0 + 0) * 72 + t] = (bf16_t)(vv[i].x & 0xffff); Vt[(v0 + 1) * 72 + t] = (bf16_t)(vv[i].x >> 16);
        Vt[(v0 + 2) * 72 + t] = (bf16_t)(vv[i].y & 0xffff); Vt[(v0 + 3) * 72 + t] = (bf16_t)(vv[i].y >> 16);
        Vt[(v0 + 4) * 72 + t] = (bf16_t)(vv[i].z & 0xffff); Vt[(v0 + 5) * 72 + t] = (bf16_t)(vv[i].z >> 16);
        Vt[(v0 + 6) * 72 + t] = (bf16_t)(vv[i].w & 0xffff); Vt[(v0 + 7) * 72 + t] = (bf16_t)(vv[i].w >> 16);
    }
    __syncthreads();
    float off = 0.f;
#pragma unroll
    for (int s4 = 0; s4 < 4; ++s4) { const float x = segs[s4 * 128 + k]; if (s4 < seg) off += x; }
    const float bref = segs[k] + segs[128 + k];
#pragma unroll
    for (int tt = 0; tt < 16; ++tt) {
        const int t = seg * 16 + tt;
        const float bt = run[tt] + off, q = bf2f(qr[tt]);
        Qi[t * 136 + k] = (bf16_t)f2bf(q * __expf(bt));
        Qa[t * 136 + k] = (bf16_t)f2bf(q * __expf(fminf(bt - bref, 80.f)));
        Ka[t * 136 + k] = (bf16_t)f2bf(kval[tt] * __expf(fminf(bref - bt, 80.f)));
    }
    __syncthreads();
    f32x4 P[4];
#pragma unroll
    for (int st = 0; st < 4; ++st) P[st] = (f32x4){0.f, 0.f, 0.f, 0.f};
#pragma unroll
    for (int ks = 0; ks < 4; ++ks) {
        const bf16x8 qf = *(const LAS bf16x8*)(Qa + (mt * 16 + fr) * 136 + ks * 32 + quad * 8);
#pragma unroll
        for (int st = 0; st < 4; ++st) {
            const bf16x8 kf = *(const LAS bf16x8*)(Ka + (st * 16 + fr) * 136 + ks * 32 + quad * 8);
            P[st] = __builtin_amdgcn_mfma_f32_16x16x32_bf16(kf, qf, P[st], 0, 0, 0);
        }
    }
    const int tq = mt * 16 + fr;
#pragma unroll
    for (int st = 0; st < 4; ++st)
#pragma unroll
        for (int e = 0; e < 4; ++e) { const int s = st * 16 + quad * 4 + e; if (s > tq) P[st][e] = 0.f; }
    bf16x8 pf[2];
#pragma unroll
    for (int kp = 0; kp < 2; ++kp) {
        u32x4 t4; t4.x = pk2(P[2 * kp][0], P[2 * kp][1]); t4.y = pk2(P[2 * kp][2], P[2 * kp][3]); t4.z = pk2(P[2 * kp + 1][0], P[2 * kp + 1][1]); t4.w = pk2(P[2 * kp + 1][2], P[2 * kp + 1][3]);
        pf[kp] = __builtin_bit_cast(bf16x8, t4);
    }
    f32x4 o[4];
#pragma unroll
    for (int n = 0; n < 4; ++n) o[n] = (f32x4){0.f, 0.f, 0.f, 0.f};
#pragma unroll
    for (int ks = 0; ks < 4; ++ks) {
        const bf16x8 qf = *(const LAS bf16x8*)(Qi + (mt * 16 + fr) * 136 + ks * 32 + quad * 8);
#pragma unroll
        for (int n = 0; n < 4; ++n) o[n] = __builtin_amdgcn_mfma_f32_16x16x32_bf16(qf, sf[ks][n], o[n], 0, 0, 0);
    }
#pragma unroll
    for (int kp = 0; kp < 2; ++kp)
#pragma unroll
        for (int n = 0; n < 4; ++n) {
            const LAS bf16_t* vp = Vt + (vh * 64 + n * 16 + fr) * 72 + 32 * kp + quad * 4;
            const u32x2 lo = *(const LAS u32x2*)vp, hi = *(const LAS u32x2*)(vp + 16);
            u32x4 t4; t4.x = lo.x; t4.y = lo.y; t4.z = hi.x; t4.w = hi.y;
            o[n] = __builtin_amdgcn_mfma_f32_16x16x32_bf16(pf[kp], __builtin_bit_cast(bf16x8, t4), o[n], 0, 0, 0);
        }
    float ssq[4];
#pragma unroll
    for (int e = 0; e < 4; ++e) {
        float s2 = (o[0][e] * o[0][e] + o[1][e] * o[1][e]) + (o[2][e] * o[2][e] + o[3][e] * o[3][e]);
        s2 += __shfl_xor(s2, 1); s2 += __shfl_xor(s2, 2); s2 += __shfl_xor(s2, 4); s2 += __shfl_xor(s2, 8);
        ssq[e] = s2;
    }
    if (fr == 0) {
#pragma unroll
        for (int e = 0; e < 4; ++e) red[vh * 64 + mt * 16 + quad * 4 + e] = ssq[e];
    }
    __syncthreads();
    float hn[4];
#pragma unroll
    for (int n = 0; n < 4; ++n) hn[n] = a->in[I_HGN][j * 512 + hh * 128 + vh * 64 + n * 16 + fr];
#pragma unroll
    for (int e = 0; e < 4; ++e) {
        const int t = mt * 16 + quad * 4 + e;
        const float rstd = rsqrtf((red[t] + red[64 + t]) * (1.0f / 128.0f) + EPS_);
#pragma unroll
        for (int n = 0; n < 4; ++n) {
            const float gv = bf2f(gr[e][n]);
            gp[(size_t)e * 2048 + n * 16] = (bf16_t)f2bf(o[n][e] * rstd * hn[n] * (gv * sigmoidf_(gv)));
        }
    }
    __syncthreads();
}

__device__ __forceinline__ void attn_unit(LAS unsigned char* lds, ArgP a, int j, int unit) {
    LAS bf16_t* Ks = (LAS bf16_t*)lds;
    LAS bf16_t* Vt = (LAS bf16_t*)(lds + 36864);
    const bf16_t* qkv = (const bf16_t*)(a->ws + WS_QKV);
    bf16_t* aout = (bf16_t*)(a->ws + WS_AOUT);
    const int tid = ltid(), lane = tid & 63, w = tid >> 6, fr = lane & 15, quad = lane >> 4;
    const int b = unit >> 8, kvh = (unit >> 6) & 3, blk = unit & 63;
    const int tokb = b * SEQ_ + blk * 128;
    u32x4 kk4[4], vv4[4];
#pragma unroll
    for (int i = 0; i < 4; ++i) {
        const int idx = tid + 512 * i, key = idx & 255, ch = idx >> 8, pos = blk * 128 - 128 + key;
        kk4[i] = (u32x4){0u, 0u, 0u, 0u}; vv4[i] = (u32x4){0u, 0u, 0u, 0u};
        if (pos >= 0) {
            const bf16_t* src = qkv + (size_t)(b * SEQ_ + pos) * 1536 + 1024 + kvh * 64 + ch * 8;
            kk4[i] = *(const u32x4*)src; vv4[i] = *(const u32x4*)(src + 256);
        }
    }
#pragma unroll
    for (int i = 0; i < 4; ++i) {
        const int idx = tid + 512 * i, key = idx & 255, ch = idx >> 8;
        const u32x4 vv = vv4[i];
        *(LAS u32x4*)(Ks + key * 72 + ch * 8) = kk4[i];
        const int d0 = ch * 8;
        Vt[(d0 + 0) * 264 + key] = (bf16_t)(vv.x & 0xffff); Vt[(d0 + 1) * 264 + key] = (bf16_t)(vv.x >> 16);
        Vt[(d0 + 2) * 264 + key] = (bf16_t)(vv.y & 0xffff); Vt[(d0 + 3) * 264 + key] = (bf16_t)(vv.y >> 16);
        Vt[(d0 + 4) * 264 + key] = (bf16_t)(vv.z & 0xffff); Vt[(d0 + 5) * 264 + key] = (bf16_t)(vv.z >> 16);
        Vt[(d0 + 6) * 264 + key] = (bf16_t)(vv.w & 0xffff); Vt[(d0 + 7) * 264 + key] = (bf16_t)(vv.w >> 16);
    }
    __syncthreads();
    const int g = w & 3, half = w >> 2, h = kvh * 4 + g;
    const float slope = exp2f(-0.5f * (float)(h + 1));
    const float sink = a->in[I_SINK][j * 16 + h];
    bf16x8 qfa[2][2][2];
#pragma unroll
    for (int it = 0; it < 2; ++it)
#pragma unroll
        for (int qt = 0; qt < 2; ++qt)
#pragma unroll
            for (int ks = 0; ks < 2; ++ks) qfa[it][qt][ks] = *(const bf16x8*)(qkv + (size_t)(tokb + half * 64 + it * 32 + 16 * qt + fr) * 1536 + h * 64 + ks * 32 + quad * 8);
#pragma unroll
    for (int it = 0; it < 2; ++it) {
        const int q0 = half * 64 + it * 32;
        bf16x8 qf[2][2];
#pragma unroll
        for (int qt = 0; qt < 2; ++qt)
#pragma unroll
            for (int ks = 0; ks < 2; ++ks) qf[qt][ks] = qfa[it][qt][ks];
        f32x4 sc[2][10];
#pragma unroll
        for (int kt = 0; kt < 10; ++kt) {
            sc[0][kt] = (f32x4){0.f, 0.f, 0.f, 0.f}; sc[1][kt] = (f32x4){0.f, 0.f, 0.f, 0.f};
#pragma unroll
            for (int ks = 0; ks < 2; ++ks) {
                const bf16x8 kf = *(const LAS bf16x8*)(Ks + (q0 + 16 * kt + fr) * 72 + ks * 32 + quad * 8);
                sc[0][kt] = __builtin_amdgcn_mfma_f32_16x16x32_bf16(kf, qf[0][ks], sc[0][kt], 0, 0, 0);
                sc[1][kt] = __builtin_amdgcn_mfma_f32_16x16x32_bf16(kf, qf[1][ks], sc[1][kt], 0, 0, 0);
            }
        }
        bf16x8 pf[2][5];
#pragma unroll
        for (int qt = 0; qt < 2; ++qt) {
            const int qi = q0 + 16 * qt + fr;
            float mx = sink;
#pragma unroll
            for (int kt = 0; kt < 10; ++kt)
#pragma unroll
                for (int e = 0; e < 4; ++e) {
                    const int si = q0 + 16 * kt + quad * 4 + e, dist = qi + 128 - si;
                    const bool valid = (dist >= 0) && (dist < 128) && (blk * 128 + si - 128 >= 0);
                    const float s = valid ? (sc[qt][kt][e] - slope * (float)dist) : -INFINITY;
                    sc[qt][kt][e] = s; mx = fmaxf(mx, s);
                }
            mx = fmaxf(mx, __shfl_xor(mx, 16)); mx = fmaxf(mx, __shfl_xor(mx, 32));
            float sum = 0.f;
#pragma unroll
            for (int kt = 0; kt < 10; ++kt)
#pragma unroll
                for (int e = 0; e < 4; ++e) { const float pe = __expf(sc[qt][kt][e] - mx); sc[qt][kt][e] = pe; sum += pe; }
            sum += __shfl_xor(sum, 16); sum += __shfl_xor(sum, 32);
            const float inv = 1.0f / (sum + __expf(sink - mx));
#pragma unroll
            for (int kp = 0; kp < 5; ++kp) {
                u32x4 t4;
                t4.x = pk2(sc[qt][2 * kp][0] * inv, sc[qt][2 * kp][1] * inv); t4.y = pk2(sc[qt][2 * kp][2] * inv, sc[qt][2 * kp][3] * inv);
                t4.z = pk2(sc[qt][2 * kp + 1][0] * inv, sc[qt][2 * kp + 1][1] * inv); t4.w = pk2(sc[qt][2 * kp + 1][2] * inv, sc[qt][2 * kp + 1][3] * inv);
                pf[qt][kp] = __builtin_bit_cast(bf16x8, t4);
            }
        }
        f32x4 o[2][4];
#pragma unroll
        for (int qt = 0; qt < 2; ++qt)
#pragma unroll
            for (int dt = 0; dt < 4; ++dt) o[qt][dt] = (f32x4){0.f, 0.f, 0.f, 0.f};
#pragma unroll
        for (int kp = 0; kp < 5; ++kp)
#pragma unroll
            for (int dt = 0; dt < 4; ++dt) {
                const LAS bf16_t* vp = Vt + (dt * 16 + fr) * 264 + q0 + 32 * kp + quad * 4;
                const u32x2 lo = *(const LAS u32x2*)vp, hi = *(const LAS u32x2*)(vp + 16);
                u32x4 t4; t4.x = lo.x; t4.y = lo.y; t4.z = hi.x; t4.w = hi.y;
                const bf16x8 vf = __builtin_bit_cast(bf16x8, t4);
                o[0][dt] = __builtin_amdgcn_mfma_f32_16x16x32_bf16(vf, pf[0][kp], o[0][dt], 0, 0, 0);
                o[1][dt] = __builtin_amdgcn_mfma_f32_16x16x32_bf16(vf, pf[1][kp], o[1][dt], 0, 0, 0);
            }
#pragma unroll
        for (int qt = 0; qt < 2; ++qt)
#pragma unroll
            for (int dt = 0; dt < 4; ++dt) {
                u32x2 w2; w2.x = pk2(o[qt][dt][0], o[qt][dt][1]); w2.y = pk2(o[qt][dt][2], o[qt][dt][3]);
                *(u32x2*)(aout + (size_t)(tokb + q0 + 16 * qt + fr) * 1024 + h * 64 + dt * 16 + quad * 4) = w2;
            }
    }
    __syncthreads();
}

#define XB_TMO      128
#define XB_XCNT(j)  (256  + 64 * (j))
#define XB_XSUB(j)  (1280 + 64 * (j))
#define XB_XGEN(j)  (2304 + 64 * (j))
#define XB_TOP      3328
#define XB_TOPGEN   3392
#define XCD_BAR_WORDS 3456
#define XB_SPIN_CAP (1u << 18)
__device__ __forceinline__ unsigned xb_ld(unsigned* p)              { return __hip_atomic_load(p, __ATOMIC_RELAXED, __HIP_MEMORY_SCOPE_AGENT); }
__device__ __forceinline__ unsigned xb_add(unsigned* p, unsigned v) { return __hip_atomic_fetch_add(p, v, __ATOMIC_RELAXED, __HIP_MEMORY_SCOPE_AGENT); }
__device__ __forceinline__ unsigned xb_xcc_id() { return (unsigned)__builtin_amdgcn_s_getreg((3 << 11) | 20) & 0xFu; }
#define XB_SPIN(cond, bar) do { unsigned _sp = 0; while (cond) { __builtin_amdgcn_s_sleep(1); \
    if ((++_sp & 255u) == 0u) { if (xb_ld(&(bar)[XB_TMO])) break; if (_sp > XB_SPIN_CAP) { atomicAdd(&(bar)[XB_TMO], 1u); break; } } } } while (0)
__device__ __forceinline__ void xcd_barrier_complete(unsigned* bar, unsigned x, unsigned& nloc, unsigned& nx) {
    const unsigned G = gridDim.x * gridDim.y * gridDim.z;
    unsigned sum, cnt, mine, sp = 0u;
    for (;;) {
        sum = 0u; cnt = 0u; mine = 0u;
#pragma unroll
        for (unsigned j = 0; j < 16; ++j) { const unsigned c = xb_ld(&bar[XB_XCNT(j)]); sum += c; cnt += (c > 0u) ? 1u : 0u; mine = (j == x) ? c : mine; }
        if (sum == G) break;
        __builtin_amdgcn_s_sleep(1);
        if ((++sp & 255u) == 0u) { if (xb_ld(&bar[XB_TMO])) break; if (sp > XB_SPIN_CAP) { atomicAdd(&bar[XB_TMO], 1u); break; } }
    }
    nloc = mine > 0u ? mine : 1u; nx = cnt > 0u ? cnt : 1u;
}
__device__ __forceinline__ void xcd_barrier(unsigned* bar, volatile LAS unsigned* st) {
    asm volatile("s_waitcnt vmcnt(0)" ::: "memory");
    __syncthreads();
    if (threadIdx.x == 0) {
        __builtin_amdgcn_s_waitcnt(0);
        const unsigned x = xb_xcc_id();
        unsigned nloc = st[0], nx = st[1];
        if (nloc == 0u) { xcd_barrier_complete(bar, x, nloc, nx); st[0] = nloc; st[1] = nx; }
        const unsigned old = xb_add(&bar[XB_XSUB(x)], 1u);
        const unsigned gen = old / nloc;
        if (old + 1u == (gen + 1u) * nloc) {
            __builtin_amdgcn_fence(__ATOMIC_RELEASE, "agent");
            asm volatile("s_waitcnt vmcnt(0)" ::: "memory");
            const unsigned og = xb_add(&bar[XB_TOP], 1u);
            const unsigned tg = og / nx;
            if (og + 1u == (tg + 1u) * nx) xb_add(&bar[XB_TOPGEN], 1u);
            else XB_SPIN(xb_ld(&bar[XB_TOPGEN]) == tg, bar);
            __builtin_amdgcn_fence(__ATOMIC_ACQUIRE, "agent");
            xb_add(&bar[XB_XGEN(x)], 1u);
            asm volatile("s_waitcnt vmcnt(0)" ::: "memory");
        } else {
            XB_SPIN(xb_ld(&bar[XB_XGEN(x)]) == gen, bar);
            __builtin_amdgcn_fence(__ATOMIC_ACQUIRE, "agent");
            asm volatile("s_waitcnt vmcnt(0)" ::: "memory");
        }
    }
    __syncthreads();
}

#define GSYNC_CG() do { asm volatile("s_waitcnt vmcnt(0)" ::: "memory"); __syncthreads(); grid.sync(); __builtin_amdgcn_fence(__ATOMIC_ACQUIRE, "agent"); asm volatile("s_waitcnt vmcnt(0)" ::: "memory"); __syncthreads(); REARG(); } while (0)
#define GSYNC() do { xcd_barrier((unsigned*)(a->ws) + 1024, (volatile LAS unsigned*)(lds + 131072 + 512)); REARG(); } while (0)
#define REARG() do { a = get_args(); ws = a->ws; HB = (bf16_t*)(ws + WS_HB); SSQ = (float*)(ws + WS_SSQ); tid = ltid(); lane = tid & 63; wave = tid >> 6; G = lgrid(); bid = lbid(); gw = bid * 8 + wave; ngw = G * 8; } while (0)
template <int I> __device__ __forceinline__ void layer_body(LAS unsigned char* lds) {
    constexpr int i = I;
    ArgP a; unsigned char* ws; bf16_t* HB; float* SSQ; int tid, lane, wave, G, bid, gw, ngw;
    REARG();
    (void)lane; (void)wave; (void)gw; (void)ngw;
        const int j = i >> 1;
        const float* hin0 = (i == 0) ? a->in[I_X] : nullptr;
        const bf16_t* mixA; int mix_lda; const bf16_t* mixB;
        if ((i & 1) == 0) {
            if (ON(2)) {
                pg8::Gemm g{HB, (const bf16_t*)(ws + WS_WIN) + (size_t)j * 2560 * 1024, T_, 2560, 1024, 1024, 1024, 1 << 20};
                pg8::StaticOrder S; S.init(T_, 2560, G, bid);
                pg8::Epi<0> E{}; E.p.ssq_in = SSQ; E.p.o1 = (bf16_t*)(ws + WS_QFIG); E.p.o2 = (bf16_t*)(ws + WS_UCAT);
                pg8::gemm_phase(lds, g, S, E);
            }
            GSYNC();
            if (ON(3)) {
                pg8::Gemm g{(const bf16_t*)(ws + WS_UCAT), (const bf16_t*)(ws + WS_EMAT) + (size_t)j * 32 * 256 * 512, T_, 256, 512, 640, 512, 4};
                pg8::StaticOrder S; S.init(T_, 256, G, bid);
                pg8::Epi<8> E{}; E.p.fout = (float*)(ws + WS_LEND);
                pg8::gemm_phase(lds, g, S, E);
                __syncthreads();
                if (ON(4)) {
                    int u0 = bid, cnt = (bid < 2048) ? (2048 - bid + G - 1) / G : 0, stp = G;
                    if (G == 256) { stp = 1; if (bid < 128) { u0 = bid * 7; cnt = 7; } else { u0 = 896 + (bid - 128) * 9; cnt = 9; } }
                    for (int q = 0; q < cnt; ++q) hg_pass1(lds, a, j, u0 + q * stp);
                }
            }
            GSYNC();
            if (ON(5)) for (int blk = bid; blk < 256; blk += G) {
                if (wave < 4) {
                    const int gt = blk * 256 + tid, bh = gt >> 12, v = (gt >> 5) & 127, kg = gt & 31;
                    bf16_t* base = (bf16_t*)(ws + WS_KVT) + (size_t)bh * 128 * 16384 + v * 128 + kg * 4;
                    const float* dbase = (const float*)(ws + WS_DBUF) + (size_t)bh * 128 * 128 + kg * 4;
                    float S4[4];
#pragma unroll
                    for (int e = 0; e < 4; ++e) S4[e] = 0.f;
                    for (int c0 = 0; c0 < 128; c0 += 16) {
                        u32x2 x[16]; f32x4 d0[16];
#pragma unroll
                        for (int q = 0; q < 16; ++q) { x[q] = *(const u32x2*)(base + (size_t)(c0 + q) * 16384); d0[q] = *(const f32x4*)(dbase + (c0 + q) * 128); }
#pragma unroll
                        for (int q = 0; q < 16; ++q) {
                            u32x2 o; o.x = pk2(S4[0], S4[1]); o.y = pk2(S4[2], S4[3]);
                            *(u32x2*)(base + (size_t)(c0 + q) * 16384) = o;
                            S4[0] = d0[q][0] * S4[0] + bflo(x[q].x); S4[1] = d0[q][1] * S4[1] + bfhi(x[q].x);
                            S4[2] = d0[q][2] * S4[2] + bflo(x[q].y); S4[3] = d0[q][3] * S4[3] + bfhi(x[q].y);
                        }
                    }
                } else if (wave == 4 && blk < 128) {
                    const int id = blk * 64 + lane, g = id >> 8, b = (id >> 6) & 3, p = id & 63;
                    const float* A32 = (const float*)(ws + WS_A32) + (size_t)(j * 32 + g) * 128;
                    const float ar = A32[p * 2], ai = A32[p * 2 + 1];
                    const size_t R0 = (size_t)g * 1024 + b * 256;
                    const float* le = (const float*)(ws + WS_LEND) + R0 * 128 + p;
                    bf16_t* uc = (bf16_t*)(ws + WS_UCAT) + R0 * 640 + 512 + p;
                    float sr = 0.f, si = 0.f;
                    for (int c0 = 0; c0 < 256; c0 += 16) {
                        float lr[16], li[16];
#pragma unroll
                        for (int q = 0; q < 16; ++q) { lr[q] = le[(size_t)(c0 + q) * 128]; li[q] = le[(size_t)(c0 + q) * 128 + 64]; }
#pragma unroll
                        for (int q = 0; q < 16; ++q) {
                            uc[(size_t)(c0 + q) * 640] = (bf16_t)f2bf(sr); uc[(size_t)(c0 + q) * 640 + 64] = (bf16_t)f2bf(si);
                            const float nr = ar * sr - ai * si + lr[q], ni = ar * si + ai * sr + li[q];
                            sr = nr; si = ni;
                        }
                    }
                }
            }
            GSYNC();
            if (ON(6)) {
                pg8::Gemm g{(const bf16_t*)(ws + WS_UCAT), (const bf16_t*)(ws + WS_BMAT) + (size_t)j * 32 * 512 * 640, T_, 512, 640, 640, 640, 4};
                pg8::StaticOrder S; S.init(T_, 512, G, bid);
                pg8::Epi<4> E{}; E.p.o1 = (bf16_t*)(ws + WS_ZBUF);
                pg8::gemm_phase(lds, g, S, E);
                __syncthreads();
                if (ON(7)) for (int u = bid; u < 2048; u += G) hg_pass3(lds, a, j, u);
            }
            GSYNC();
            if (ON(8)) {
                pg8::Gemm g{(const bf16_t*)(ws + WS_ZBUF), (const bf16_t*)(ws + WS_WGLU) + (size_t)j * 512 * 512, T_, 512, 512, 512, 512, 1 << 20};
                pg8::StaticOrder S; S.init(T_, 512, G, bid);
                pg8::Epi<5> E{}; E.p.o1 = (bf16_t*)(ws + WS_QFIG); E.p.aux = (const bf16_t*)(ws + WS_ZBUF); E.p.bias = a->in[I_BGLU] + j * 512;
                pg8::gemm_phase(lds, g, S, E);
            }
            GSYNC();
            mixA = (const bf16_t*)(ws + WS_QFIG) + 1024; mix_lda = 2048; mixB = (const bf16_t*)(ws + WS_WOUT) + (size_t)j * 1024 * 1024;
        } else {
            if (ON(9)) {
                pg8::Gemm g{HB, (const bf16_t*)(ws + WS_WQKV) + (size_t)j * 1536 * 1024, T_, 1536, 1024, 1024, 1024, 1 << 20};
                pg8::StaticOrder S; S.init(T_, 1536, G, bid);
                pg8::Epi<1> E{}; E.p.ssq_in = SSQ; E.p.o1 = (bf16_t*)(ws + WS_QKV);
                pg8::gemm_phase(lds, g, S, E);
            }
            GSYNC();
            if (ON(10)) for (int u = bid; u < 1024; u += G) attn_unit(lds, a, j, u);
            GSYNC();
            mixA = (const bf16_t*)(ws + WS_AOUT); mix_lda = 1024; mixB = (const bf16_t*)(ws + WS_WO) + (size_t)j * 1024 * 1024;
        }
        if (ON(11)) {
            pg8::Gemm g{mixA, mixB, T_, 1024, 1024, mix_lda, 1024, 1 << 20};
            pg8::StaticOrder S; S.init(T_, 1024, G, bid);
            pg8::Epi<6> E{}; E.p.hin = hin0; E.p.hb = HB; E.p.ssq_out = SSQ;
            pg8::gemm_phase(lds, g, S, E);
        }
        GSYNC();
        if (ON(12)) {
            const float* pp = a->in[I_P] + (size_t)i * T_ * 256;
            bf16_t* pb = (bf16_t*)(ws + WS_PB);
            for (size_t e = (size_t)bid * 512 + tid; e < (size_t)T_ * 256 / 8; e += (size_t)G * 512 * 4) {
                f32x4 v0[4], v1[4];
#pragma unroll
                for (int q = 0; q < 4; ++q) { const size_t ee = e + (size_t)q * G * 512; if (ee < (size_t)T_ * 256 / 8) { v0[q] = *(const f32x4*)(pp + ee * 8); v1[q] = *(const f32x4*)(pp + ee * 8 + 4); } }
#pragma unroll
                for (int q = 0; q < 4; ++q) { const size_t ee = e + (size_t)q * G * 512; if (ee < (size_t)T_ * 256 / 8) {
                    u32x4 o; o.x = pk2(v0[q][0], v0[q][1]); o.y = pk2(v0[q][2], v0[q][3]); o.z = pk2(v1[q][0], v1[q][1]); o.w = pk2(v1[q][2], v1[q][3]);
                    *(u32x4*)(pb + ee * 8) = o; } }
            }
            pg8::Gemm g{HB, (const bf16_t*)(ws + WS_W1) + (size_t)i * 4096 * 1024, T_, 4096, 1024, 1024, 1024, 1 << 20};
            pg8::StaticOrder S; S.init(T_, 4096, G, bid);
            pg8::Epi<2> E{}; E.p.ssq_in = SSQ; E.p.o1 = (bf16_t*)(ws + WS_HID);
            pg8::gemm_phase(lds, g, S, E);
        }
        GSYNC();
        if (ON(13)) {
            pg8::Gemm g{(const bf16_t*)(ws + WS_HID), (const bf16_t*)(ws + WS_W2) + (size_t)i * 4096 * 1024, T_, 1024, 4096, 4096, 4096, 1 << 20};
            pg8::StaticOrder S; S.init(T_, 1024, G, bid);
            pg8::Epi<6> E{}; E.p.hin = nullptr; E.p.hb = HB; E.p.ssq_out = SSQ;
            pg8::gemm_phase(lds, g, S, E);
        }
        GSYNC();
        if (ON(14)) {
            pg8::Gemm g{HB, (const bf16_t*)(ws + WS_WG) + (size_t)i * 1024 * 1024, T_, 1024, 1024, 1024, 1024, 1 << 20};
            pg8::StaticOrder S; S.init(T_, 1024, G, bid);
            pg8::Epi<3> E{}; E.p.ssq_in = SSQ; E.p.o1 = (bf16_t*)(ws + WS_SIG);
            pg8::gemm_phase(lds, g, S, E);
        }
        GSYNC();
        if (ON(15)) {
            pg8::Gemm g{(const bf16_t*)(ws + WS_PB), (const bf16_t*)(ws + WS_WUP) + (size_t)i * 256 * 1024, T_, 1024, 256, 256, 256, 1 << 20};
            pg8::StaticOrder S; S.init(T_, 1024, G, bid);
            pg8::Epi<7> E{}; E.p.hin = nullptr; E.p.hb = HB; E.p.ssq_out = SSQ; E.p.aux = (const bf16_t*)(ws + WS_SIG);
            pg8::gemm_phase(lds, g, S, E);
        }
        GSYNC();
    }

__global__ void __launch_bounds__(512, 2) trunk_fwd(Args a_unused) {
    ArgP a = get_args();
    extern __shared__ __attribute__((aligned(16))) unsigned char lds_raw[];
    LAS unsigned char* lds = (LAS unsigned char*)lds_raw;
    cg::grid_group grid = cg::this_grid();
    int tid = ltid(), lane = tid & 63, wave = tid >> 6;
    int G = lgrid(), bid = lbid();
    int gw = bid * 8 + wave, ngw = G * 8;
    unsigned char* ws = a->ws;
    bf16_t* HB = (bf16_t*)(ws + WS_HB);
    float* SSQ = (float*)(ws + WS_SSQ);

    if (bid == 0) { unsigned* bw_ = (unsigned*)ws + 1024; for (int q = tid; q < XCD_BAR_WORDS; q += 512) __hip_atomic_store(bw_ + q, 0u, __ATOMIC_RELAXED, __HIP_MEMORY_SCOPE_AGENT); }
    asm volatile("s_waitcnt vmcnt(0)" ::: "memory"); __syncthreads();
    grid.sync();
    if (tid == 0) { volatile LAS unsigned* st_ = (volatile LAS unsigned*)(lds + 131072 + 512); st_[0] = 0u; st_[1] = 0u;
        (void)xb_add(((unsigned*)ws + 1024) + XB_XCNT(xb_xcc_id()), 1u); }
    __syncthreads();
    if (ON(0)) for (int u = bid; u < 256; u += G) s5_tables(lds, a, u >> 7, (u >> 2) & 31, u & 3);
    if (ON(1)) {
        LAS float* scr = (LAS float*)(lds + wave * 8448);
        for (int j = 0; j < 2; ++j) {
            transpose_matrix(a->in[I_WIN] + (size_t)j * 1024 * 2560, 1024, 2560, (bf16_t*)(ws + WS_WIN) + (size_t)j * 2560 * 1024, a->in[I_MIXN] + (2 * j) * 1024, scr, gw, ngw, lane);
            transpose_matrix(a->in[I_WOUT] + (size_t)j * 1024 * 1024, 1024, 1024, (bf16_t*)(ws + WS_WOUT) + (size_t)j * 1024 * 1024, nullptr, scr, gw, ngw, lane);
            transpose_matrix(a->in[I_WGLU] + (size_t)j * 512 * 512, 512, 512, (bf16_t*)(ws + WS_WGLU) + (size_t)j * 512 * 512, nullptr, scr, gw, ngw, lane);
            transpose_matrix(a->in[I_WQKV] + (size_t)j * 1024 * 1536, 1024, 1536, (bf16_t*)(ws + WS_WQKV) + (size_t)j * 1536 * 1024, a->in[I_MIXN] + (2 * j + 1) * 1024, scr, gw, ngw, lane);
            transpose_matrix(a->in[I_WO] + (size_t)j * 1024 * 1024, 1024, 1024, (bf16_t*)(ws + WS_WO) + (size_t)j * 1024 * 1024, nullptr, scr, gw, ngw, lane);
        }
        for (int i = 0; i < 4; ++i) {
            transpose_matrix(a->in[I_W1] + (size_t)i * 1024 * 4096, 1024, 4096, (bf16_t*)(ws + WS_W1) + (size_t)i * 4096 * 1024, a->in[I_MLPN] + i * 1024, scr, gw, ngw, lane);
            transpose_matrix(a->in[I_W2] + (size_t)i * 4096 * 1024, 4096, 1024, (bf16_t*)(ws + WS_W2) + (size_t)i * 4096 * 1024, nullptr, scr, gw, ngw, lane);
            transpose_matrix(a->in[I_WUP] + (size_t)i * 256 * 1024, 256, 1024, (bf16_t*)(ws + WS_WUP) + (size_t)i * 256 * 1024, nullptr, scr, gw, ngw, lane);
            transpose_matrix(a->in[I_WG] + (size_t)i * 1024 * 1024, 1024, 1024, (bf16_t*)(ws + WS_WG) + (size_t)i * 1024 * 1024, a->in[I_PLEN] + i * 1024, scr, gw, ngw, lane);
        }
    }
    for (int r = gw; r < T_; r += ngw) {
        const f32x4* xr = (const f32x4*)(a->in[I_X] + (size_t)r * 1024) + lane;
        float s = 0.f;
        unsigned long long* o8 = (unsigned long long*)(HB + (size_t)r * 1024) + lane;
        f32x4 xv[4];
#pragma unroll
        for (int q = 0; q < 4; ++q) xv[q] = xr[64 * q];
#pragma unroll
        for (int q = 0; q < 4; ++q) { const f32x4 v = xv[q]; s += (v[0] * v[0] + v[1] * v[1]) + (v[2] * v[2] + v[3] * v[3]);
            o8[64 * q] = (unsigned long long)pk2(v[0], v[1]) | ((unsigned long long)pk2(v[2], v[3]) << 32); }
        s = wave_sum(s);
        if (lane < 16) SSQ[(size_t)r * 16 + lane] = (lane == 0) ? s : 0.f;
    }
    GSYNC();


    layer_body<0>(lds); REARG();
    layer_body<1>(lds); REARG();
    layer_body<2>(lds); REARG();
    layer_body<3>(lds); REARG();
    for (int r = gw; r < T_; r += ngw) {
        const float rs = row_rstd(SSQ, r);
        f32x4* xr = (f32x4*)(a->out + (size_t)r * 1024) + lane;
        const u32x2* hr = (const u32x2*)(HB + (size_t)r * 1024) + lane;
        const f32x4* gr = (const f32x4*)a->in[I_FINN] + lane;
        u32x2 hw4[4]; f32x4 gg4[4];
#pragma unroll
        for (int q = 0; q < 4; ++q) { hw4[q] = hr[64 * q]; gg4[q] = gr[64 * q]; }
#pragma unroll
        for (int q = 0; q < 4; ++q) { const u32x2 hw = hw4[q]; f32x4 v; v[0] = bflo(hw.x); v[1] = bfhi(hw.x); v[2] = bflo(hw.y); v[3] = bfhi(hw.y); v = v * rs * gg4[q]; xr[64 * q] = v; }
    }
}

extern "C" void kernel_launch(void* const* d_in, const int* in_sizes, int n_in, void* d_out, int out_size, void* d_ws, size_t ws_size, hipStream_t stream) {
    static int grid = 0;
    if (grid == 0) {
        if (n_in != 27 || ws_size < WS_END) { fprintf(stderr, "kernel_launch: unexpected n_in %d / ws_size %zu (need %zu)\n", n_in, ws_size, (size_t)WS_END); grid = -1; return; }
        int dev = 0, cus = 0, per_cu = 0;
        hipGetDevice(&dev);
        hipDeviceGetAttribute(&cus, hipDeviceAttributeMultiprocessorCount, dev);
        hipFuncSetAttribute((const void*)trunk_fwd, hipFuncAttributeMaxDynamicSharedMemorySize, LDS_BYTES);
        hipOccupancyMaxActiveBlocksPerMultiprocessor(&per_cu, (const void*)trunk_fwd, 512, LDS_BYTES);
        if (per_cu < 1) per_cu = 1;
        grid = cus * per_cu;
        (void)hipGetLastError();
    }
    if (grid < 0) return;
    Args a{};
    for (int i = 0; i < 27; ++i) a.in[i] = (const float*)d_in[i];
    a.out = (float*)d_out; a.ws = (unsigned char*)d_ws;
    void* args[] = {&a};
    hipError_t e = hipLaunchCooperativeKernel((const void*)trunk_fwd, dim3(grid), dim3(512), args, LDS_BYTES, stream);
    if (e != hipSuccess) fprintf(stderr, "cooperative launch failed: %s (grid %d)\n", hipGetErrorString(e), grid);
}
```

```cpp
#include <hip/hip_runtime.h>
#include <hip/hip_cooperative_groups.h>
#include <cstdio>
#include <cstdint>
namespace cg = cooperative_groups;

#define LAS __attribute__((address_space(3)))
typedef unsigned short bf16_t;
typedef short bf16x8 __attribute__((ext_vector_type(8)));
typedef short s16x4 __attribute__((ext_vector_type(4)));
typedef float f32x4 __attribute__((ext_vector_type(4)));
typedef unsigned u32x4 __attribute__((ext_vector_type(4)));
typedef unsigned u32x2 __attribute__((ext_vector_type(2)));

constexpr int T_ = 32768, D_ = 1024, SEQ_ = 8192;
constexpr float EPS_ = 1e-6f;
constexpr size_t MiB = 1ull << 20;
constexpr size_t WS_WIN = 1 * MiB;
constexpr size_t WS_WOUT = 11 * MiB;
constexpr size_t WS_WGLU = 15 * MiB;
constexpr size_t WS_WQKV = 16 * MiB;
constexpr size_t WS_WO = 22 * MiB;
constexpr size_t WS_W1 = 26 * MiB;
constexpr size_t WS_W2 = 58 * MiB;
constexpr size_t WS_WUP = 90 * MiB;
constexpr size_t WS_WG = 92 * MiB;
constexpr size_t WS_BMAT = 100 * MiB;
constexpr size_t WS_EMAT = 140 * MiB;
constexpr size_t WS_A32 = 156 * MiB;
constexpr size_t WS_HB = 157 * MiB;
constexpr size_t WS_SSQ = 221 * MiB;
constexpr size_t WS_R = 223 * MiB;
constexpr size_t WS_QFIG = WS_R;
constexpr size_t WS_UCAT = WS_R + 128 * MiB;
constexpr size_t WS_LEND = WS_R + 168 * MiB;
constexpr size_t WS_ZBUF = WS_R + 184 * MiB;
constexpr size_t WS_KVT = WS_R + 216 * MiB;
constexpr size_t WS_DBUF = WS_R + 280 * MiB;
constexpr size_t WS_QKV = WS_R;
constexpr size_t WS_AOUT = WS_R + 96 * MiB;
constexpr size_t WS_HID = WS_R;
constexpr size_t WS_PB = WS_R + 256 * MiB;
constexpr size_t WS_SIG = WS_R;
constexpr size_t WS_END = WS_R + 281 * MiB;

constexpr int LDS_BYTES = 147456;
#ifndef PH
#define PH 0xFFFFFF
#endif
#define ON(n) ((PH >> (n)) & 1)

__device__ __forceinline__ int ltid() { int t = threadIdx.x; asm volatile("" : "+v"(t)); return t; }
__device__ __forceinline__ int lbid() { int b = blockIdx.x; asm volatile("" : "+s"(b)); return b; }
__device__ __forceinline__ int lgrid() { int g = gridDim.x; asm volatile("" : "+s"(g)); return g; }
__device__ __forceinline__ unsigned f2bf(float f) { unsigned u = __float_as_uint(f); return (u + 0x7fffu + ((u >> 16) & 1u)) >> 16; }
__device__ __forceinline__ float bf2f(unsigned b) { return __uint_as_float(b << 16); }
__device__ __forceinline__ float bflo(unsigned w) { return __uint_as_float(w << 16); }
__device__ __forceinline__ float bfhi(unsigned w) { return __uint_as_float(w & 0xffff0000u); }
typedef float f32x2_t __attribute__((ext_vector_type(2)));
typedef __bf16 bf16x2_t __attribute__((ext_vector_type(2)));
__device__ __forceinline__ unsigned pk2(float lo, float hi) { const f32x2_t v = {lo, hi}; const bf16x2_t b = __builtin_convertvector(v, bf16x2_t); return __builtin_bit_cast(unsigned, b); }
__device__ __forceinline__ float sigmoidf_(float x) { return __builtin_amdgcn_rcpf(1.0f + __expf(-x)); }
__device__ __forceinline__ float gelu_tanh(float x) { const float u = 0.7978845608028654f * (x + 0.044715f * x * x * x); return x * sigmoidf_(2.0f * u); }
__device__ __forceinline__ float log_sigmoid_(float z) { return fminf(z, 0.f) - log1pf(__expf(-fabsf(z))); }
__device__ __forceinline__ float logaddexp_(float a, float b) { const float m = fmaxf(a, b); return m + log1pf(__expf(-fabsf(a - b))); }
__device__ __forceinline__ float row_rstd(const float* ssq, int row) {
    const f32x4* p = (const f32x4*)(ssq + (size_t)row * 16);
    const f32x4 a = p[0], b = p[1], c = p[2], d = p[3];
    const float s = (((a[0] + a[1]) + (a[2] + a[3])) + ((b[0] + b[1]) + (b[2] + b[3]))) + (((c[0] + c[1]) + (c[2] + c[3])) + ((d[0] + d[1]) + (d[2] + d[3])));
    return rsqrtf(s * (1.0f / 1024.0f) + EPS_);
}

__device__ __forceinline__ float row_rstd4(const float* ssq, unsigned row, int fq) {
    const f32x4 a = *(const f32x4*)(ssq + (row * 16u + (unsigned)fq * 4u));
    float s = (a[0] + a[1]) + (a[2] + a[3]);
    s += __shfl_xor(s, 16); s += __shfl_xor(s, 32);
    return rsqrtf(s * (1.0f / 1024.0f) + EPS_);
}

namespace pg8 {
constexpr int BM = 256, BK = 64, HALF = 128, HTB = HALF * BK * 2, STAGE_BYTES = 8 * HTB, NXCD = 8, WGM = 8;
__host__ __device__ __forceinline__ int lds_byte(int r, int c) { const int st = (r >> 4) * 2 + (c >> 5), rr = r & 15, cc = c & 31, ob = rr * 64 + cc * 2; return st * 1024 + (ob ^ (((ob >> 9) & 1) << 5)); }
__host__ __device__ __forceinline__ void stage_rc(int b, int& R, int& C) { const int st = b / 1024, sb = b % 1024, swz = sb ^ (((sb >> 9) & 1) << 5); R = (st >> 1) * 16 + swz / 64; C = (st & 1) * 32 + (swz % 64) / 2; }
__host__ __device__ __forceinline__ int perm32(int rho) { const int n = rho >> 4, i = rho & 15; return 8 * (i >> 2) + 4 * n + (i & 3); }

struct Unit { int pm, pn; };
struct Gemm { const bf16_t* A; const bf16_t* Bt; int M, N, K, lda, ldb, mtpg; };

struct StaticOrder {
    int nM, nN, nwg, G, c;
    __device__ void init(int M, int N, int G_, int c_) { nM = M / BM; nN = N / BM; nwg = nM * nN; G = G_; c = c_; }
    __device__ bool next(int i, Unit& u) const {
        const long L = (long)i * G + c; if (L >= nwg) return false;
        int wgid = (int)L; { const int q = nwg / NXCD, r = nwg % NXCD, xcd = wgid % NXCD, off = wgid / NXCD; wgid = (xcd < r ? xcd * (q + 1) : r * (q + 1) + (xcd - r) * q) + off; }
        const int nig = WGM * nN, gid = wgid / nig, fm = gid * WGM, gsz = (nM - fm) < WGM ? (nM - fm) : WGM;
        u.pm = fm + ((wgid % nig) % gsz); u.pn = (wgid % nig) / gsz; return true;
    }
};

struct EpiP {
    const float* ssq_in; float* ssq_out; const float* hin; float* hout; bf16_t* hb;
    bf16_t* o1; bf16_t* o2; const bf16_t* aux; const float* bias; float* fout;
};

template <int MODE> struct Epi {
    static constexpr bool PERM = (MODE <= 5);
    EpiP p;
    static constexpr bool RSTD = (MODE <= 3);
    __device__ __forceinline__ void operator()(const f32x4 (&acc)[2][2][4][2], const Unit& u, int wr, int wc, int fr_, int fq_, bool use_tab, const LAS float* rt) const {
        int fr = fr_, fq = fq_;
        asm volatile("" : "+v"(fr), "+v"(fq));
        const int row0 = u.pm * BM + wr * 64 + fr;
        if constexpr (MODE <= 5) {
            const int colt = u.pn * BM + wc * 32 + 8 * fq;
            float rsv[2][4];
#pragma unroll
            for (int ai = 0; ai < 2; ++ai)
#pragma unroll
                for (int m = 0; m < 4; ++m) {
                    rsv[ai][m] = 1.0f;
                }
            if constexpr (MODE <= 3) {
              if (use_tab) {
#pragma unroll
                for (int ai = 0; ai < 2; ++ai)
#pragma unroll
                    for (int m = 0; m < 4; ++m) rsv[ai][m] = rt[wr * 64 + fr + ai * HALF + m * 16];
              } else {
                f32x4 pv[2][4];
#pragma unroll
                for (int ai = 0; ai < 2; ++ai)
#pragma unroll
                    for (int m = 0; m < 4; ++m) pv[ai][m] = *(const f32x4*)(p.ssq_in + ((unsigned)(row0 + ai * HALF + m * 16) * 16u + (unsigned)fq * 4u));
#pragma unroll
                for (int ai = 0; ai < 2; ++ai)
#pragma unroll
                    for (int m = 0; m < 4; ++m) { float sx = (pv[ai][m][0] + pv[ai][m][1]) + (pv[ai][m][2] + pv[ai][m][3]); sx += __shfl_xor(sx, 16); sx += __shfl_xor(sx, 32); rsv[ai][m] = rsqrtf(sx * (1.0f / 1024.0f) + EPS_); }
              }
            }
#pragma unroll
            for (int ai = 0; ai < 2; ++ai)
#pragma unroll
                for (int m = 0; m < 4; ++m) {
                    const int row = row0 + ai * HALF + m * 16;
                    float rs = rsv[ai][m];
                    if constexpr (MODE == 1) { if (u.pn < 4) rs *= 0.125f; }
                    u32x4 zpre[2];
                    if constexpr (MODE == 5) { zpre[0] = *(const u32x4*)(p.aux + (unsigned)(row * 512 + colt)); zpre[1] = *(const u32x4*)(p.aux + (unsigned)(row * 512 + colt + HALF)); }
#pragma unroll
                    for (int bj = 0; bj < 2; ++bj) {
                        const int col = colt + bj * HALF;
                        f32x4 v0 = acc[ai][bj][m][0] * rs, v1 = acc[ai][bj][m][1] * rs;
                        bf16_t* dest;
                        if constexpr (MODE == 0) {
                            if (u.pn < 2) dest = p.o2 + (unsigned)(((col >> 4) * 1024 + (row >> 5)) * 640 + (row & 31) * 16 + (col & 15));
                            else dest = p.o1 + (unsigned)(row * 2048 + (col - 512));
                        } else if constexpr (MODE == 1) {
                            dest = p.o1 + (unsigned)(row * 1536 + col);
                        } else if constexpr (MODE == 2) {
#pragma unroll
                            for (int e = 0; e < 4; ++e) { float a = fmaxf(v0[e], 0.f), b = fmaxf(v1[e], 0.f); v0[e] = a * a; v1[e] = b * b; }
                            dest = p.o1 + (unsigned)(row * 4096 + col);
                        } else if constexpr (MODE == 3) {
#pragma unroll
                            for (int e = 0; e < 4; ++e) { v0[e] = sigmoidf_(v0[e]); v1[e] = sigmoidf_(v1[e]); }
                            dest = p.o1 + (unsigned)(row * 1024 + col);
                        } else if constexpr (MODE == 4) {
#pragma unroll
                            for (int e = 0; e < 4; ++e) { v0[e] = gelu_tanh(v0[e]); v1[e] = gelu_tanh(v1[e]); }
                            const int g = row >> 10, bc = row & 1023, tok = bc * 32 + (col >> 4);
                            dest = p.o1 + (unsigned)(tok * 512 + g * 16 + (col & 15));
                        } else {
                            const u32x4 z = zpre[bj];
                            const f32x4 b0 = *(const f32x4*)(p.bias + col), b1 = *(const f32x4*)(p.bias + col + 4);
                            v0[0] = bflo(z.x) * sigmoidf_(v0[0] + b0[0]); v0[1] = bfhi(z.x) * sigmoidf_(v0[1] + b0[1]);
                            v0[2] = bflo(z.y) * sigmoidf_(v0[2] + b0[2]); v0[3] = bfhi(z.y) * sigmoidf_(v0[3] + b0[3]);
                            v1[0] = bflo(z.z) * sigmoidf_(v1[0] + b1[0]); v1[1] = bfhi(z.z) * sigmoidf_(v1[1] + b1[1]);
                            v1[2] = bflo(z.w) * sigmoidf_(v1[2] + b1[2]); v1[3] = bfhi(z.w) * sigmoidf_(v1[3] + b1[3]);
                            dest = p.o1 + (unsigned)(row * 2048 + 1024 + col);
                        }
                        u32x4 w; w.x = pk2(v0[0], v0[1]); w.y = pk2(v0[2], v0[3]); w.z = pk2(v1[0], v1[1]); w.w = pk2(v1[2], v1[3]);
                        *(u32x4*)dest = w;
                    }
                    if (m & 1) asm volatile("" ::: "memory");
                }
        } else if constexpr (MODE == 6 || MODE == 7) {
            const int col0 = u.pn * BM + wc * 32 + 4 * fq;
#pragma unroll
            for (int ai = 0; ai < 2; ++ai)
#pragma unroll
                for (int m = 0; m < 4; ++m) {
                    const int row = row0 + ai * HALF + m * 16;
                    float ss = 0.f;
                    f32x4 hv[2][2]; u32x2 sgv[2][2];
#pragma unroll
                    for (int bj = 0; bj < 2; ++bj)
#pragma unroll
                        for (int n = 0; n < 2; ++n) {
                            const unsigned off = (unsigned)(row * 1024 + col0 + bj * HALF + n * 16);
                            if (p.hin) hv[bj][n] = *(const f32x4*)(p.hin + off);
                            else { const u32x2 hw = *(const u32x2*)(p.hb + off); hv[bj][n][0] = bflo(hw.x); hv[bj][n][1] = bfhi(hw.x); hv[bj][n][2] = bflo(hw.y); hv[bj][n][3] = bfhi(hw.y); }
                            if constexpr (MODE == 7) sgv[bj][n] = *(const u32x2*)(p.aux + off);
                        }
#pragma unroll
                    for (int bj = 0; bj < 2; ++bj)
#pragma unroll
                        for (int n = 0; n < 2; ++n) {
                            const unsigned off = (unsigned)(row * 1024 + col0 + bj * HALF + n * 16);
                            f32x4 a = acc[ai][bj][m][n];
                            if constexpr (MODE == 7) { const u32x2 sg = sgv[bj][n]; a[0] *= bflo(sg.x); a[1] *= bfhi(sg.x); a[2] *= bflo(sg.y); a[3] *= bfhi(sg.y); }
                            const f32x4 v = hv[bj][n] + a;
                            u32x2 w; w.x = pk2(v[0], v[1]); w.y = pk2(v[2], v[3]);
                            *(u32x2*)(p.hb + off) = w;
                            ss += (v[0] * v[0] + v[1] * v[1]) + (v[2] * v[2] + v[3] * v[3]);
                        }
                    ss += __shfl_xor(ss, 16); ss += __shfl_xor(ss, 32);
                    if (fq == 0) p.ssq_out[(unsigned)(row * 16 + u.pn * 4 + wc)] = ss;
                    if (m & 1) asm volatile("" ::: "memory");
                }
        } else {
            const int col0 = wc * 32 + 4 * fq;
#pragma unroll
            for (int ai = 0; ai < 2; ++ai)
#pragma unroll
                for (int m = 0; m < 4; ++m) {
                    const int row = row0 + ai * HALF + m * 16;
#pragma unroll
                    for (int n = 0; n < 2; ++n) *(f32x4*)(p.fout + (unsigned)(row * 128 + col0 + n * 16)) = acc[ai][0][m][n];
                }
        }
    }
};

template <class EpiT>
__device__ __forceinline__ void gemm_phase(LAS unsigned char* lds, const Gemm g, const StaticOrder& S, const EpiT& E) {
    const int tid = ltid(), wid = __builtin_amdgcn_readfirstlane(tid >> 6), lane = tid & 63, wr = wid >> 2, wc = wid & 3, fr = lane & 15, fq = lane >> 4;
    const int K = g.K, nt = K / BK;
    unsigned voffA[2], voffB[2];
#pragma unroll
    for (int i = 0; i < 2; ++i) { int R, C; stage_rc(tid * 16 + i * 8192, R, C); const int Rb = EpiT::PERM ? ((R & ~31) + perm32(R & 31)) : R;
        voffA[i] = (unsigned)(R * g.lda + C) * 2u; voffB[i] = (unsigned)(Rb * g.ldb + C) * 2u; }
    constexpr unsigned kstep = BK * 2;
    const unsigned hstepA = (unsigned)(HALF * g.lda * 2), hstepB = (unsigned)(HALF * g.ldb * 2);
    const unsigned tstepA = 2 * hstepA, tstepB = 2 * hstepB;
    const int nNt = g.N / BM;
    const unsigned ldsw = (unsigned)wid * 1024u;
    const int aoff = lds_byte(wr * 64 + fr, fq * 8), boff = lds_byte(wc * 32 + fr, fq * 8);
#define PG8_SA(b, h) (((b) * 2 + (h)) * HTB)
#define PG8_SB(b, h) ((4 + (b) * 2 + (h)) * HTB)
#define PG8_STAGE(bufoff, gbase, voff) do { _Pragma("unroll") for (int _i = 0; _i < 2; ++_i) \
        __builtin_amdgcn_global_load_lds((const unsigned*)((const char*)(gbase) + (voff)[_i]), (LAS unsigned*)(lds + (bufoff) + ldsw + _i * 8192), 16, 0, 0); } while (0)
#define PG8_LDA(dst, b, h) do { _Pragma("unroll") for (int m = 0; m < 4; ++m) _Pragma("unroll") for (int k = 0; k < 2; ++k) dst[m][k] = *(const LAS bf16x8*)(lds + PG8_SA(b, h) + aoff + m * 2048 + k * 1024); } while (0)
#define PG8_LDB(dst, b, h) do { _Pragma("unroll") for (int n = 0; n < 2; ++n) _Pragma("unroll") for (int k = 0; k < 2; ++k) dst[n][k] = *(const LAS bf16x8*)(lds + PG8_SB(b, h) + boff + n * 2048 + k * 1024); } while (0)
#define PG8_MMA(ai, bj, At, Bt) do { __builtin_amdgcn_s_setprio(1); _Pragma("unroll") for (int m = 0; m < 4; ++m) _Pragma("unroll") for (int n = 0; n < 2; ++n) _Pragma("unroll") for (int k = 0; k < 2; ++k) \
        acc[ai][bj][m][n] = __builtin_amdgcn_mfma_f32_16x16x32_bf16(Bt[n][k], At[m][k], acc[ai][bj][m][n], 0, 0, 0); __builtin_amdgcn_s_setprio(0); } while (0)
#define PG8_WAIT_V(n) asm volatile("s_waitcnt vmcnt(" #n ")" ::: "memory")
#define PG8_WAIT_L(n) asm volatile("s_waitcnt lgkmcnt(" #n ")" ::: "memory")
#define PG8_BAR __builtin_amdgcn_s_barrier()
#define PG8_SCHED __builtin_amdgcn_sched_barrier(0)
#define PG8_BBASE(u) ((const char*)g.Bt + (size_t)(((u).pm / g.mtpg) * nNt + (u).pn) * tstepB)
    Unit cur, nxt; int ui = 0;
    if (!S.next(0, cur)) return;
    LAS float* rtab = (LAS float*)(lds + STAGE_BYTES + 2048);
    bool use_tab = false; int nun = 0;
    const int rr = tid & 255, ih = __builtin_amdgcn_readfirstlane(tid >> 8);
    f32x4 pv[4][4];
    if constexpr (EpiT::RSTD) {
        { Unit uu; while (nun <= 8 && S.next(nun, uu)) ++nun; }
        use_tab = (nun <= 8);
        if (use_tab) {
#pragma unroll
            for (int ps = 0; ps < 4; ++ps) { const int i = 2 * ps + ih; Unit uu; if (i < nun && S.next(i, uu)) { const f32x4* sp = (const f32x4*)(E.p.ssq_in + (size_t)(uu.pm * BM + rr) * 16);
#pragma unroll
                for (int q = 0; q < 4; ++q) pv[ps][q] = sp[q]; } }
        }
    }
    f32x4 acc[2][2][4][2];
#pragma unroll
    for (int a = 0; a < 2; ++a)
#pragma unroll
        for (int b = 0; b < 2; ++b)
#pragma unroll
            for (int m = 0; m < 4; ++m)
#pragma unroll
                for (int n = 0; n < 2; ++n) acc[a][b][m][n] = (f32x4){0.f, 0.f, 0.f, 0.f};
    bf16x8 At[4][2], B0[2][2], B1[2][2];
    const char* cA = (const char*)g.A + (size_t)cur.pm * tstepA; const char* cB = PG8_BBASE(cur);
    PG8_STAGE(PG8_SB(0, 0), cB, voffB); PG8_STAGE(PG8_SB(0, 1), cB + hstepB, voffB); PG8_STAGE(PG8_SA(0, 0), cA, voffA); PG8_STAGE(PG8_SA(0, 1), cA + hstepA, voffA);
    if constexpr (EpiT::RSTD) {
        if (use_tab) {
#pragma unroll
            for (int ps = 0; ps < 4; ++ps) { const int i = 2 * ps + ih; if (i < nun) {
                const float sx = (((pv[ps][0][0] + pv[ps][0][1]) + (pv[ps][0][2] + pv[ps][0][3])) + ((pv[ps][1][0] + pv[ps][1][1]) + (pv[ps][1][2] + pv[ps][1][3])))
                               + (((pv[ps][2][0] + pv[ps][2][1]) + (pv[ps][2][2] + pv[ps][2][3])) + ((pv[ps][3][0] + pv[ps][3][1]) + (pv[ps][3][2] + pv[ps][3][3])));
                rtab[i * 256 + rr] = rsqrtf(sx * (1.0f / 1024.0f) + EPS_); } }
            asm volatile("s_waitcnt lgkmcnt(0)" ::: "memory");
        }
    }
    if (wr == 1) PG8_BAR;
    PG8_WAIT_V(2); PG8_BAR;
    PG8_STAGE(PG8_SB(1, 0), cB + kstep, voffB); PG8_STAGE(PG8_SA(1, 0), cA + kstep, voffA); PG8_STAGE(PG8_SB(1, 1), cB + hstepB + kstep, voffB);
    PG8_WAIT_V(6); PG8_BAR;
    for (;;) {
        const bool has_next = S.next(ui + 1, nxt);
        const char* nA = has_next ? (const char*)g.A + (size_t)nxt.pm * tstepA : cA; const char* nB = has_next ? PG8_BBASE(nxt) : cB;
        for (int t = 0; t < nt; t += 2) {
            const bool last = (t == nt - 2);
            const char* a1 = cA + (size_t)(t + 1) * kstep;
            const char* a2 = last ? nA : cA + (size_t)(t + 2) * kstep; const char* b2 = last ? nB : cB + (size_t)(t + 2) * kstep;
            const char* a3 = a2 + kstep; const char* b3 = b2 + kstep;
            PG8_LDB(B0, 0, 0); PG8_LDB(B1, 0, 1); PG8_SCHED; PG8_LDA(At, 0, 0); PG8_STAGE(PG8_SA(1, 1), a1 + hstepA, voffA);
            PG8_WAIT_V(8); PG8_WAIT_L(0); PG8_BAR; PG8_MMA(0, 0, At, B0); PG8_MMA(0, 1, At, B1); PG8_BAR; PG8_SCHED;
            PG8_LDA(At, 0, 1); PG8_STAGE(PG8_SB(0, 0), b2, voffB); PG8_STAGE(PG8_SB(0, 1), b2 + hstepB, voffB); PG8_STAGE(PG8_SA(0, 0), a2, voffA);
            PG8_WAIT_V(8); PG8_WAIT_L(0); PG8_BAR; PG8_MMA(1, 0, At, B0); PG8_MMA(1, 1, At, B1); PG8_BAR; PG8_SCHED;
            PG8_LDB(B0, 1, 0); PG8_LDB(B1, 1, 1); PG8_SCHED; PG8_LDA(At, 1, 0); PG8_STAGE(PG8_SA(0, 1), a2 + hstepA, voffA);
            PG8_WAIT_V(8); PG8_WAIT_L(0); PG8_BAR; PG8_MMA(0, 0, At, B0); PG8_MMA(0, 1, At, B1); PG8_BAR; PG8_SCHED;
            PG8_LDA(At, 1, 1); PG8_STAGE(PG8_SB(1, 0), b3, voffB); PG8_STAGE(PG8_SB(1, 1), b3 + hstepB, voffB); PG8_STAGE(PG8_SA(1, 0), a3, voffA);
            PG8_WAIT_V(8); PG8_WAIT_L(0); PG8_BAR; PG8_MMA(1, 0, At, B0); PG8_MMA(1, 1, At, B1); PG8_BAR; PG8_SCHED;
        }
        if (wr == 0) PG8_BAR;
        E(acc, cur, wr, wc, fr, fq, use_tab, rtab + ui * 256);
        if (!has_next) break;
#pragma unroll
        for (int a = 0; a < 2; ++a)
#pragma unroll
            for (int b = 0; b < 2; ++b)
#pragma unroll
                for (int m = 0; m < 4; ++m)
#pragma unroll
                    for (int n = 0; n < 2; ++n) acc[a][b][m][n] = (f32x4){0.f, 0.f, 0.f, 0.f};
        cur = nxt; cA = nA; cB = nB; ++ui;
        if (wr == 1) PG8_BAR;
    }
    PG8_WAIT_V(0);
    PG8_BAR;
#undef PG8_SA
#undef PG8_SB
#undef PG8_STAGE
#undef PG8_LDA
#undef PG8_LDB
#undef PG8_MMA
#undef PG8_WAIT_V
#undef PG8_WAIT_L
#undef PG8_BAR
#undef PG8_SCHED
#undef PG8_BBASE
}
}

struct Args { const float* in[27]; float* out; unsigned char* ws; };
typedef const __attribute__((address_space(4))) Args* ArgP;
__device__ __forceinline__ ArgP get_args() { auto p = __builtin_amdgcn_kernarg_segment_ptr(); asm volatile("" : "+s"(p)); return (ArgP)p; }
enum { I_X = 0, I_P, I_MIXN, I_MLPN, I_PLEN, I_FINN, I_WIN, I_WOUT, I_LRE, I_LIM, I_LDT, I_BRE, I_BIM, I_CRE, I_CIM, I_SD, I_WGLU, I_BGLU,
       I_LBL, I_HGN, I_WQKV, I_WO, I_SINK, I_W1, I_W2, I_WUP, I_WG };

__device__ __forceinline__ void transpose_item(const float* W, int K, int N, bf16_t* WT, const float* gain, LAS float* scr, int item, int lane) {
    const int nblk = N / 32, kb = item / nblk, nb = item % nblk, k0 = 64 * kb, n0 = 32 * nb;
    float wv[32];
#pragma unroll
    for (int i = 0; i < 32; ++i) wv[i] = W[(size_t)(k0 + 2 * i + (lane >> 5)) * N + n0 + (lane & 31)];
    if (gain) {
        float gv[32];
#pragma unroll
        for (int i = 0; i < 32; ++i) gv[i] = gain[k0 + 2 * i + (lane >> 5)];
#pragma unroll
        for (int i = 0; i < 32; ++i) wv[i] *= gv[i];
    }
#pragma unroll
    for (int i = 0; i < 32; ++i) scr[(2 * i + (lane >> 5)) * 33 + (lane & 31)] = wv[i];
    asm volatile("s_waitcnt lgkmcnt(0)" ::: "memory");
    const int c = lane & 7;
#pragma unroll
    for (int j = 0; j < 4; ++j) { const int n = (lane >> 3) + 8 * j; const LAS float* s = scr + (8 * c) * 33 + n;
        u32x4 o; o.x = pk2(s[0 * 33], s[1 * 33]); o.y = pk2(s[2 * 33], s[3 * 33]); o.z = pk2(s[4 * 33], s[5 * 33]); o.w = pk2(s[6 * 33], s[7 * 33]);
        *(u32x4*)(WT + (size_t)(n0 + n) * K + k0 + 8 * c) = o; }
    asm volatile("s_waitcnt lgkmcnt(0)" ::: "memory");
}

__device__ __forceinline__ void transpose_matrix(const float* W, int K, int N, bf16_t* WT, const float* gain, LAS float* scr, int gw, int ngw, int lane) {
    const int items = (K / 64) * (N / 32);
    for (int it = gw; it < items; it += ngw) transpose_item(W, K, N, WT, gain, scr, it, lane);
}

__device__ __forceinline__ void s5_tables(LAS unsigned char* lds, ArgP a, int j, int g, int qt) {
    LAS float* Wr = (LAS float*)lds;
    LAS float* Wi = Wr + 33 * 64;
    LAS float* Bbr = Wi + 33 * 64;
    LAS float* Bbi = Bbr + 1024;
    LAS float* Cr = Bbi + 1024;
    LAS float* Ci = Cr + 1024;
    LAS float* Kt = Ci + 1024;
    const int tid = ltid();
    const int jg = j * 32 + g;
    const float dt = expf(a->in[I_LDT][jg]);
    for (int it = tid; it < 33 * 64; it += 512) {
        const int tau = it >> 6, p = it & 63;
        const float lr = fminf(a->in[I_LRE][jg * 64 + p], -1e-4f), li = a->in[I_LIM][jg * 64 + p];
        const float mag = expf(lr * dt * (float)tau); float sn, cs; sincosf(li * dt * (float)tau, &sn, &cs);
        Wr[it] = mag * cs; Wi[it] = mag * sn;
    }
    for (int it = tid; it < 1024; it += 512) { Cr[it] = a->in[I_CRE][(size_t)jg * 1024 + it]; Ci[it] = a->in[I_CIM][(size_t)jg * 1024 + it]; }
    __syncthreads();
    for (int it = tid; it < 1024; it += 512) {
        const int p = it >> 4;
        const float lr = fminf(a->in[I_LRE][jg * 64 + p], -1e-4f), li = a->in[I_LIM][jg * 64 + p];
        const float ar = Wr[64 + p], ai = Wi[64 + p];
        const float den = lr * lr + li * li, xr = ar - 1.0f;
        const float zr = (xr * lr + ai * li) / den, zi = (ai * lr - xr * li) / den;
        const float br = a->in[I_BRE][(size_t)jg * 1024 + it], bi = a->in[I_BIM][(size_t)jg * 1024 + it];
        Bbr[it] = zr * br - zi * bi; Bbi[it] = zr * bi + zi * br;
    }
    __syncthreads();
    {
        const int pair = tid & 255, half = tid >> 8, h = pair >> 4, hp = pair & 15;
        const int nh = 4 * (qt + 1), tau0 = half * nh;
        float ka[16];
#pragma unroll
        for (int tt = 0; tt < 16; ++tt) ka[tt] = 0.f;
        for (int p = 0; p < 64; ++p) {
            const float cr = Cr[h * 64 + p], ci = Ci[h * 64 + p], br = Bbr[p * 16 + hp], bi = Bbi[p * 16 + hp];
            const float cbr = cr * br - ci * bi, cbi = cr * bi + ci * br;
#pragma unroll
            for (int tt = 0; tt < 16; ++tt) if (tt < nh) ka[tt] += cbr * Wr[(tau0 + tt) * 64 + p] - cbi * Wi[(tau0 + tt) * 64 + p];
        }
#pragma unroll
        for (int tt = 0; tt < 16; ++tt) if (tt < nh) {
            const int tau = tau0 + tt; float v = ka[tt];
            if (tau == 0 && h == hp) v += a->in[I_SD][jg * 16 + h];
            Kt[(tau * 16 + h) * 16 + hp] = v;
        }
    }
    __syncthreads();
    bf16_t* Bmat = (bf16_t*)(a->ws + WS_BMAT) + (size_t)jg * 512 * 640;
    for (int ch = tid; ch < 128 * 80; ch += 512) {
        const int row = qt * 128 + ch / 80, c8 = ch % 80, t = row >> 4, h = row & 15;
        float v[8];
        if (c8 < 64) {
            const int jj = c8 >> 1, h0 = (c8 & 1) * 8, tau = t - jj;
#pragma unroll
            for (int e = 0; e < 8; ++e) v[e] = (tau >= 0) ? Kt[(tau * 16 + h) * 16 + h0 + e] : 0.f;
        } else {
            const int im = (c8 >= 72), p0 = (c8 - (im ? 72 : 64)) * 8;
#pragma unroll
            for (int e = 0; e < 8; ++e) { const int p = p0 + e; const float cr = Cr[h * 64 + p], ci = Ci[h * 64 + p], wr = Wr[(t + 1) * 64 + p], wi = Wi[(t + 1) * 64 + p];
                v[e] = im ? -(cr * wi + ci * wr) : (cr * wr - ci * wi); }
        }
        u32x4 o; o.x = pk2(v[0], v[1]); o.y = pk2(v[2], v[3]); o.z = pk2(v[4], v[5]); o.w = pk2(v[6], v[7]);
        *(u32x4*)(Bmat + (size_t)row * 640 + c8 * 8) = o;
    }
    bf16_t* Emat = (bf16_t*)(a->ws + WS_EMAT) + (size_t)jg * 256 * 512;
    for (int ch = tid; ch < 64 * 64; ch += 512) {
        const int pr = qt * 64 + (ch >> 6), c8 = ch & 63, jj = c8 >> 1, h0 = (c8 & 1) * 8;
        float v[8];
        if (pr < 128) {
            const int p = pr & 63, im = pr >> 6; const float wr = Wr[(31 - jj) * 64 + p], wi = Wi[(31 - jj) * 64 + p];
#pragma unroll
            for (int e = 0; e < 8; ++e) { const float br = Bbr[p * 16 + h0 + e], bi = Bbi[p * 16 + h0 + e]; v[e] = im ? (wr * bi + wi * br) : (wr * br - wi * bi); }
        } else {
#pragma unroll
            for (int e = 0; e < 8; ++e) v[e] = 0.f;
        }
        u32x4 o; o.x = pk2(v[0], v[1]); o.y = pk2(v[2], v[3]); o.z = pk2(v[4], v[5]); o.w = pk2(v[6], v[7]);
        *(u32x4*)(Emat + (size_t)pr * 512 + c8 * 8) = o;
    }
    float* A32 = (float*)(a->ws + WS_A32) + (size_t)jg * 128;
    if (qt == 0 && tid < 64) { A32[tid * 2] = Wr[32 * 64 + tid]; A32[tid * 2 + 1] = Wi[32 * 64 + tid]; }
    __syncthreads();
}

__device__ __forceinline__ float wave_sum(float v) {
#pragma unroll
    for (int o = 1; o < 64; o <<= 1) v += __shfl_xor(v, o);
    return v;
}

__device__ __forceinline__ float hg_lb(ArgP a, int j, int ch) {
    if (j == 0) return 0.f;
    const float l0 = a->in[I_LBL][ch], l1 = a->in[I_LBL][512 + ch];
    return 1.0f / (1.0f + expf(l0 - l1));
}
__device__ __forceinline__ void hg_gate(float z, float lbm, float oml, float& lf, float& kval) {
    const float zc = fminf(fmaxf(z, -30.f), 30.f);
    const float e = __expf(-zc), r = __builtin_amdgcn_rcpf(1.0f + e);
    lf = __logf(lbm + oml * r); kval = oml * (e * r);
}

__device__ __forceinline__ void hg_pass1(LAS unsigned char* lds, ArgP a, int j, int unit) {
    LAS float* segs = (LAS float*)lds;
    LAS bf16_t* Kh = (LAS bf16_t*)(lds + 2048);
    LAS bf16_t* Vt = (LAS bf16_t*)(lds + 2048 + 18432);
    const bf16_t* qfig = (const bf16_t*)(a->ws + WS_QFIG);
    bf16_t* kvt = (bf16_t*)(a->ws + WS_KVT) + (size_t)unit * 16384;
    float* dbuf = (float*)(a->ws + WS_DBUF) + (size_t)unit * 128;
    const int tid = ltid(), lane = tid & 63, w = tid >> 6, fr = lane & 15, quad = lane >> 4;
    const int b = unit >> 9, hh = (unit >> 7) & 3, c = unit & 127;
    const int tok0 = b * SEQ_ + c * 64;
    const int k = tid & 127, seg = tid >> 7;
    unsigned zr[16];
    const bf16_t* zp = qfig + (size_t)(tok0 + seg * 16) * 2048 + 512 + hh * 128 + k;
#pragma unroll
    for (int tt = 0; tt < 16; ++tt) zr[tt] = zp[(size_t)tt * 2048];
    u32x4 vv[2];
#pragma unroll
    for (int i = 0; i < 2; ++i) { const int idx = tid + 512 * i; vv[i] = *(const u32x4*)(qfig + (size_t)(tok0 + (idx & 63)) * 2048 + 1024 + hh * 128 + (idx >> 6) * 8); }
    const float lb = hg_lb(a, j, hh * 128 + k);
    const float lbm = fmaxf(lb, 1e-30f), oml = 1.0f - lb;
    float run[16], kval[16]; float acc_ = 0.f;
#pragma unroll
    for (int tt = 0; tt < 16; ++tt) { float lf; hg_gate(bf2f(zr[tt]), lbm, oml, lf, kval[tt]); acc_ += lf; run[tt] = acc_; }
    segs[seg * 128 + k] = acc_;
#pragma unroll
    for (int i = 0; i < 2; ++i) {
        const int idx = tid + 512 * i, t = idx & 63, v0 = (idx >> 6) * 8;
        Vt[(v0 + 0) * 72 + t] = (bf16_t)(vv[i].x & 0xffff); Vt[(v0 + 1) * 72 + t] = (bf16_t)(vv[i].x >> 16);
        Vt[(v0 + 2) * 72 + t] = (bf16_t)(vv[i].y & 0xffff); Vt[(v0 + 3) * 72 + t] = (bf16_t)(vv[i].y >> 16);
        Vt[(v0 + 4) * 72 + t] = (bf16_t)(vv[i].z & 0xffff); Vt[(v0 + 5) * 72 + t] = (bf16_t)(vv[i].z >> 16);
        Vt[(v0 + 6) * 72 + t] = (bf16_t)(vv[i].w & 0xffff); Vt[(v0 + 7) * 72 + t] = (bf16_t)(vv[i].w >> 16);
    }
    __syncthreads();
    float off = 0.f, total = 0.f;
#pragma unroll
    for (int s4 = 0; s4 < 4; ++s4) { const float x = segs[s4 * 128 + k]; total += x; if (s4 < seg) off += x; }
    const float rem = total - off;
#pragma unroll
    for (int tt = 0; tt < 16; tt += 4) {
        u32x2 o; o.x = pk2(kval[tt] * __expf(rem - run[tt]), kval[tt + 1] * __expf(rem - run[tt + 1]));
        o.y = pk2(kval[tt + 2] * __expf(rem - run[tt + 2]), kval[tt + 3] * __expf(rem - run[tt + 3]));
        *(LAS u32x2*)(Kh + k * 72 + seg * 16 + tt) = o;
    }
    if (seg == 0) dbuf[k] = __expf(total);
    __syncthreads();
    bf16x8 vf[2];
#pragma unroll
    for (int ks = 0; ks < 2; ++ks) vf[ks] = *(const LAS bf16x8*)(Vt + (w * 16 + fr) * 72 + ks * 32 + quad * 8);
#pragma unroll
    for (int kt = 0; kt < 8; ++kt) {
        f32x4 acc = (f32x4){0.f, 0.f, 0.f, 0.f};
#pragma unroll
        for (int ks = 0; ks < 2; ++ks) {
            const bf16x8 kf = *(const LAS bf16x8*)(Kh + (kt * 16 + fr) * 72 + ks * 32 + quad * 8);
            acc = __builtin_amdgcn_mfma_f32_16x16x32_bf16(kf, vf[ks], acc, 0, 0, 0);
        }
        u32x2 o; o.x = pk2(acc[0], acc[1]); o.y = pk2(acc[2], acc[3]);
        *(u32x2*)(kvt + (size_t)(w * 16 + fr) * 128 + kt * 16 + quad * 4) = o;
    }
    __syncthreads();
}

__device__ __forceinline__ void hg_pass3(LAS unsigned char* lds, ArgP a, int j, int unit) {
    LAS float* segs = (LAS float*)lds;
    LAS float* red = segs + 512;
    LAS bf16_t* Qi = (LAS bf16_t*)(lds + 4096);
    LAS bf16_t* Qa = (LAS bf16_t*)(lds + 4096 + 17408);
    LAS bf16_t* Ka = (LAS bf16_t*)(lds + 4096 + 2 * 17408);
    LAS bf16_t* Vt = (LAS bf16_t*)(lds + 4096 + 3 * 17408);
    bf16_t* qfig = (bf16_t*)(a->ws + WS_QFIG);
    const bf16_t* St = (const bf16_t*)(a->ws + WS_KVT) + (size_t)unit * 16384;
    const int tid = ltid(), lane = tid & 63, w = tid >> 6, fr = lane & 15, quad = lane >> 4;
    const int b = unit >> 9, hh = (unit >> 7) & 3, c = unit & 127;
    const int tok0 = b * SEQ_ + c * 64;
    const int k = tid & 127, seg = tid >> 7;
    const int mt = w & 3, vh = w >> 2;
    unsigned zr[16], qr[16];
    const bf16_t* zp = qfig + (size_t)(tok0 + seg * 16) * 2048 + hh * 128 + k;
#pragma unroll
    for (int tt = 0; tt < 16; ++tt) { zr[tt] = zp[(size_t)tt * 2048 + 512]; qr[tt] = zp[(size_t)tt * 2048]; }
    u32x4 vv[2];
#pragma unroll
    for (int i = 0; i < 2; ++i) { const int idx = tid + 512 * i; vv[i] = *(const u32x4*)(qfig + (size_t)(tok0 + (idx & 63)) * 2048 + 1024 + hh * 128 + (idx >> 6) * 8); }
    bf16x8 sf[4][4];
#pragma unroll
    for (int ks = 0; ks < 4; ++ks)
#pragma unroll
        for (int n = 0; n < 4; ++n) sf[ks][n] = *(const bf16x8*)(St + (size_t)(vh * 64 + n * 16 + fr) * 128 + ks * 32 + quad * 8);
    unsigned gr[4][4];
    bf16_t* gp = qfig + (size_t)(tok0 + mt * 16 + quad * 4) * 2048 + 1536 + hh * 128 + vh * 64 + fr;
#pragma unroll
    for (int e = 0; e < 4; ++e)
#pragma unroll
        for (int n = 0; n < 4; ++n) gr[e][n] = gp[(size_t)e * 2048 + n * 16];
    const float lb = hg_lb(a, j, hh * 128 + k);
    const float lbm = fmaxf(lb, 1e-30f), oml = 1.0f - lb;
    float run[16], kval[16]; float acc_ = 0.f;
#pragma unroll
    for (int tt = 0; tt < 16; ++tt) { float lf; hg_gate(bf2f(zr[tt]), lbm, oml, lf, kval[tt]); acc_ += lf; run[tt] = acc_; }
    segs[seg * 128 + k] = acc_;
#pragma unroll
    for (int i = 0; i < 2; ++i) {
        const int idx = tid + 512 * i, t = idx & 63, v0 = (idx >> 6) * 8;
        Vt[(v0 + 0) * 72 + t] = (bf16_t)(vv[i].x & 0xffff); Vt[(v0 + 1) * 72 + t] = (bf16_t)(vv[i].x >> 16);
        Vt[(v0 + 2) * 72 + t] = (bf16_t)(vv[i].y & 0xffff); Vt[(v0 + 3) * 72 + t] = (bf16_t)(vv[i].y >> 16);
        Vt[(v0 + 4) * 72 + t] = (bf16_t)(vv[i].z & 0xffff); Vt[(v0 + 5) * 72 + t] = (bf16_t)(vv[i].z >> 16);
        Vt[(v0 + 6) * 72 + t] = (bf16_t)(vv[i].w & 0xffff); Vt[(v0 + 7) * 72 + t] = (bf16_t)(vv[i].w >> 16);
    }
    __syncthreads();
    float off = 0.f;
#pragma unroll
    for (int s4 = 0; s4 < 4; ++s4) { const float x = segs[s4 * 128 + k]; if (s4 < seg) off += x; }
    const float bref = segs[k] + segs[128 + k];
#pragma unroll
    for (int tt = 0; tt < 16; ++tt) {
        const int t = seg * 16 + tt;
        const float bt = run[tt] + off, q = bf2f(qr[tt]);
        Qi[t * 136 + k] = (bf16_t)f2bf(q * __expf(bt));
        Qa[t * 136 + k] = (bf16_t)f2bf(q * __expf(fminf(bt - bref, 80.f)));
        Ka[t * 136 + k] = (bf16_t)f2bf(kval[tt] * __expf(fminf(bref - bt, 80.f)));
    }
    __syncthreads();
    f32x4 P[4];
#pragma unroll
    for (int st = 0; st < 4; ++st) P[st] = (f32x4){0.f, 0.f, 0.f, 0.f};
#pragma unroll
    for (int ks = 0; ks < 4; ++ks) {
        const bf16x8 qf = *(const LAS bf16x8*)(Qa + (mt * 16 + fr) * 136 + ks * 32 + quad * 8);
#pragma unroll
        for (int st = 0; st < 4; ++st) {
            const bf16x8 kf = *(const LAS bf16x8*)(Ka + (st * 16 + fr) * 136 + ks * 32 + quad * 8);
            P[st] = __builtin_amdgcn_mfma_f32_16x16x32_bf16(kf, qf, P[st], 0, 0, 0);
        }
    }
    const int tq = mt * 16 + fr;
#pragma unroll
    for (int st = 0; st < 4; ++st)
#pragma unroll
        for (int e = 0; e < 4; ++e) { const int s = st * 16 + quad * 4 + e; if (s > tq) P[st][e] = 0.f; }
    bf16x8 pf[2];
#pragma unroll
    for (int kp = 0; kp < 2; ++kp) {
        u32x4 t4; t4.x = pk2(P[2 * kp][0], P[2 * kp][1]); t4.y = pk2(P[2 * kp][2], P[2 * kp][3]); t4.z = pk2(P[2 * kp + 1][0], P[2 * kp + 1][1]); t4.w = pk2(P[2 * kp + 1][2], P[2 * kp + 1][3]);
        pf[kp] = __builtin_bit_cast(bf16x8, t4);
    }
    f32x4 o[4];
#pragma unroll
    for (int n = 0; n < 4; ++n) o[n] = (f32x4){0.f, 0.f, 0.f, 0.f};
#pragma unroll
    for (int ks = 0; ks < 4; ++ks) {
        const bf16x8 qf = *(const LAS bf16x8*)(Qi + (mt * 16 + fr) * 136 + ks * 32 + quad * 8);
#pragma unroll
        for (int n = 0; n < 4; ++n) o[n] = __builtin_amdgcn_mfma_f32_16x16x32_bf16(qf, sf[ks][n], o[n], 0, 0, 0);
    }
#pragma unroll
    for (int kp = 0; kp < 2; ++kp)
#pragma unroll
        for (int n = 0; n < 4; ++n) {
            const LAS bf16_t* vp = Vt + (vh * 64 + n * 16 + fr) * 72 + 32 * kp + quad * 4;
            const u32x2 lo = *(const LAS u32x2*)vp, hi = *(const LAS u32x2*)(vp + 16);
            u32x4 t4; t4.x = lo.x; t4.y = lo.y; t4.z = hi.x; t4.w = hi.y;
            o[n] = __builtin_amdgcn_mfma_f32_16x16x32_bf16(pf[kp], __builtin_bit_cast(bf16x8, t4), o[n], 0, 0, 0);
        }
    float ssq[4];
#pragma unroll
    for (int e = 0; e < 4; ++e) {
        float s2 = (o[0][e] * o[0][e] + o[1][e] * o[1][e]) + (o[2][e] * o[2][e] + o[3][e] * o[3][e]);
        s2 += __shfl_xor(s2, 1); s2 += __shfl_xor(s2, 2); s2 += __shfl_xor(s2, 4); s2 += __shfl_xor(s2, 8);
        ssq[e] = s2;
    }
    if (fr == 0) {
#pragma unroll
        for (int e = 0; e < 4; ++e) red[vh * 64 + mt * 16 + quad * 4 + e] = ssq[e];
    }
    __syncthreads();
    float hn[4];
#pragma unroll
    for (int n = 0; n < 4; ++n) hn[n] = a->in[I_HGN][j * 512 + hh * 128 + vh * 64 + n * 16 + fr];
#pragma unroll
    for (int e = 0; e < 4; ++e) {
        const int t = mt * 16 + quad * 4 + e;
        const float rstd = rsqrtf((red[t] + red[64 + t]) * (1.0f / 128.0f) + EPS_);
#pragma unroll
        for (int n = 0; n < 4; ++n) {
            const float gv = bf2f(gr[e][n]);
            gp[(size_t)e * 2048 + n * 16] = (bf16_t)f2bf(o[n][e] * rstd * hn[n] * (gv * sigmoidf_(gv)));
        }
    }
    __syncthreads();
}

__device__ __forceinline__ void attn_unit(LAS unsigned char* lds, ArgP a, int j, int unit) {
    LAS bf16_t* Ks = (LAS bf16_t*)lds;
    LAS bf16_t* Vt = (LAS bf16_t*)(lds + 36864);
    const bf16_t* qkv = (const bf16_t*)(a->ws + WS_QKV);
    bf16_t* aout = (bf16_t*)(a->ws + WS_AOUT);
    const int tid = ltid(), lane = tid & 63, w = tid >> 6, fr = lane & 15, quad = lane >> 4;
    const int b = unit >> 8, kvh = (unit >> 6) & 3, blk = unit & 63;
    const int tokb = b * SEQ_ + blk * 128;
    u32x4 kk4[4], vv4[4];
#pragma unroll
    for (int i = 0; i < 4; ++i) {
        const int idx = tid + 512 * i, key = idx & 255, ch = idx >> 8, pos = blk * 128 - 128 + key;
        kk4[i] = (u32x4){0u, 0u, 0u, 0u}; vv4[i] = (u32x4){0u, 0u, 0u, 0u};
        if (pos >= 0) {
            const bf16_t* src = qkv + (size_t)(b * SEQ_ + pos) * 1536 + 1024 + kvh * 64 + ch * 8;
            kk4[i] = *(const u32x4*)src; vv4[i] = *(const u32x4*)(src + 256);
        }
    }
#pragma unroll
    for (int i = 0; i < 4; ++i) {
        const int idx = tid + 512 * i, key = idx & 255, ch = idx >> 8;
        const u32x4 vv = vv4[i];
        *(LAS u32x4*)(Ks + key * 72 + ch * 8) = kk4[i];
        const int d0 = ch * 8;
        Vt[(d0 + 0) * 264 + key] = (bf16_t)(vv.x & 0xffff); Vt[(d0 + 1) * 264 + key] = (bf16_t)(vv.x >> 16);
        Vt[(d0 + 2) * 264 + key] = (bf16_t)(vv.y & 0xffff); Vt[(d0 + 3) * 264 + key] = (bf16_t)(vv.y >> 16);
        Vt[(d0 + 4) * 264 + key] = (bf16_t)(vv.z & 0xffff); Vt[(d0 + 5) * 264 + key] = (bf16_t)(vv.z >> 16);
        Vt[(d0 + 6) * 264 + key] = (bf16_t)(vv.w & 0xffff); Vt[(d0 + 7) * 264 + key] = (bf16_t)(vv.w >> 16);
    }
    __syncthreads();
    const int g = w & 3, half = w >> 2, h = kvh * 4 + g;
    const float slope = exp2f(-0.5f * (float)(h + 1));
    const float sink = a->in[I_SINK][j * 16 + h];
    bf16x8 qfa[2][2][2];
#pragma unroll
    for (int it = 0; it < 2; ++it)
#pragma unroll
        for (int qt = 0; qt < 2; ++qt)
#pragma unroll
            for (int ks = 0; ks < 2; ++ks) qfa[it][qt][ks] = *(const bf16x8*)(qkv + (size_t)(tokb + half * 64 + it * 32 + 16 * qt + fr) * 1536 + h * 64 + ks * 32 + quad * 8);
#pragma unroll
    for (int it = 0; it < 2; ++it) {
        const int q0 = half * 64 + it * 32;
        bf16x8 qf[2][2];
#pragma unroll
        for (int qt = 0; qt < 2; ++qt)
#pragma unroll
            for (int ks = 0; ks < 2; ++ks) qf[qt][ks] = qfa[it][qt][ks];
        f32x4 sc[2][10];
#pragma unroll
        for (int kt = 0; kt < 10; ++kt) {
            sc[0][kt] = (f32x4){0.f, 0.f, 0.f, 0.f}; sc[1][kt] = (f32x4){0.f, 0.f, 0.f, 0.f};
#pragma unroll
            for (int ks = 0; ks < 2; ++ks) {
                const bf16x8 kf = *(const LAS bf16x8*)(Ks + (q0 + 16 * kt + fr) * 72 + ks * 32 + quad * 8);
                sc[0][kt] = __builtin_amdgcn_mfma_f32_16x16x32_bf16(kf, qf[0][ks], sc[0][kt], 0, 0, 0);
                sc[1][kt] = __builtin_amdgcn_mfma_f32_16x16x32_bf16(kf, qf[1][ks], sc[1][kt], 0, 0, 0);
            }
        }
        bf16x8 pf[2][5];
#pragma unroll
        for (int qt = 0; qt < 2; ++qt) {
            const int qi = q0 + 16 * qt + fr;
            float mx = sink;
#pragma unroll
            for (int kt = 0; kt < 10; ++kt)
#pragma unroll
                for (int e = 0; e < 4; ++e) {
                    const int si = q0 + 16 * kt + quad * 4 + e, dist = qi + 128 - si;
                    const bool valid = (dist >= 0) && (dist < 128) && (blk * 128 + si - 128 >= 0);
                    const float s = valid ? (sc[qt][kt][e] - slope * (float)dist) : -INFINITY;
                    sc[qt][kt][e] = s; mx = fmaxf(mx, s);
                }
            mx = fmaxf(mx, __shfl_xor(mx, 16)); mx = fmaxf(mx, __shfl_xor(mx, 32));
            float sum = 0.f;
#pragma unroll
            for (int kt = 0; kt < 10; ++kt)
#pragma unroll
                for (int e = 0; e < 4; ++e) { const float pe = __expf(sc[qt][kt][e] - mx); sc[qt][kt][e] = pe; sum += pe; }
            sum += __shfl_xor(sum, 16); sum += __shfl_xor(sum, 32);
            const float inv = 1.0f / (sum + __expf(sink - mx));
#pragma unroll
            for (int kp = 0; kp < 5; ++kp) {
                u32x4 t4;
                t4.x = pk2(sc[qt][2 * kp][0] * inv, sc[qt][2 * kp][1] * inv); t4.y = pk2(sc[qt][2 * kp][2] * inv, sc[qt][2 * kp][3] * inv);
                t4.z = pk2(sc[qt][2 * kp + 1][0] * inv, sc[qt][2 * kp + 1][1] * inv); t4.w = pk2(sc[qt][2 * kp + 1][2] * inv, sc[qt][2 * kp + 1][3] * inv);
                pf[qt][kp] = __builtin_bit_cast(bf16x8, t4);
            }
        }
        f32x4 o[2][4];
#pragma unroll
        for (int qt = 0; qt < 2; ++qt)
#pragma unroll
            for (int dt = 0; dt < 4; ++dt) o[qt][dt] = (f32x4){0.f, 0.f, 0.f, 0.f};
#pragma unroll
        for (int kp = 0; kp < 5; ++kp)
#pragma unroll
            for (int dt = 0; dt < 4; ++dt) {
                const LAS bf16_t* vp = Vt + (dt * 16 + fr) * 264 + q0 + 32 * kp + quad * 4;
                const u32x2 lo = *(const LAS u32x2*)vp, hi = *(const LAS u32x2*)(vp + 16);
                u32x4 t4; t4.x = lo.x; t4.y = lo.y; t4.z = hi.x; t4.w = hi.y;
                const bf16x8 vf = __builtin_bit_cast(bf16x8, t4);
                o[0][dt] = __builtin_amdgcn_mfma_f32_16x16x32_bf16(vf, pf[0][kp], o[0][dt], 0, 0, 0);
                o[1][dt] = __builtin_amdgcn_mfma_f32_16x16x32_bf16(vf, pf[1][kp], o[1][dt], 0, 0, 0);
            }
#pragma unroll
        for (int qt = 0; qt < 2; ++qt)
#pragma unroll
            for (int dt = 0; dt < 4; ++dt) {
                u32x2 w2; w2.x = pk2(o[qt][dt][0], o[qt][dt][1]); w2.y = pk2(o[qt][dt][2], o[qt][dt][3]);
                *(u32x2*)(aout + (size_t)(tokb + q0 + 16 * qt + fr) * 1024 + h * 64 + dt * 16 + quad * 4) = w2;
            }
    }
    __syncthreads();
}

#define XB_TMO      128
#define XB_XCNT(j)  (256  + 64 * (j))
#define XB_XSUB(j)  (1280 + 64 * (j))
#define XB_XGEN(j)  (2304 + 64 * (j))
#define XB_TOP      3328
#define XB_TOPGEN   3392
#define XCD_BAR_WORDS 3456
#define XB_SPIN_CAP (1u << 18)
__device__ __forceinline__ unsigned xb_ld(unsigned* p)              { return __hip_atomic_load(p, __ATOMIC_RELAXED, __HIP_MEMORY_SCOPE_AGENT); }
__device__ __forceinline__ unsigned xb_add(unsigned* p, unsigned v) { return __hip_atomic_fetch_add(p, v, __ATOMIC_RELAXED, __HIP_MEMORY_SCOPE_AGENT); }
__device__ __forceinline__ unsigned xb_xcc_id() { return (unsigned)__builtin_amdgcn_s_getreg((3 << 11) | 20) & 0xFu; }
#define XB_SPIN(cond, bar) do { unsigned _sp = 0; while (cond) { __builtin_amdgcn_s_sleep(1); \
    if ((++_sp & 255u) == 0u) { if (xb_ld(&(bar)[XB_TMO])) break; if (_sp > XB_SPIN_CAP) { atomicAdd(&(bar)[XB_TMO], 1u); break; } } } } while (0)
__device__ __forceinline__ void xcd_barrier_complete(unsigned* bar, unsigned x, unsigned& nloc, unsigned& nx) {
    const unsigned G = gridDim.x * gridDim.y * gridDim.z;
    unsigned sum, cnt, mine, sp = 0u;
    for (;;) {
        sum = 0u; cnt = 0u; mine = 0u;
#pragma unroll
        for (unsigned j = 0; j < 16; ++j) { const unsigned c = xb_ld(&bar[XB_XCNT(j)]); sum += c; cnt += (c > 0u) ? 1u : 0u; mine = (j == x) ? c : mine; }
        if (sum == G) break;
        __builtin_amdgcn_s_sleep(1);
        if ((++sp & 255u) == 0u) { if (xb_ld(&bar[XB_TMO])) break; if (sp > XB_SPIN_CAP) { atomicAdd(&bar[XB_TMO], 1u); break; } }
    }
    nloc = mine > 0u ? mine : 1u; nx = cnt > 0u ? cnt : 1u;
}
__device__ __forceinline__ void xcd_barrier(unsigned* bar, volatile LAS unsigned* st) {
    asm volatile("s_waitcnt vmcnt(0)" ::: "memory");
    __syncthreads();
    if (threadIdx.x == 0) {
        __builtin_amdgcn_s_waitcnt(0);
        const unsigned x = xb_xcc_id();
        unsigned nloc = st[0], nx = st[1];
        if (nloc == 0u) { xcd_barrier_complete(bar, x, nloc, nx); st[0] = nloc; st[1] = nx; }
        const unsigned old = xb_add(&bar[XB_XSUB(x)], 1u);
        const unsigned gen = old / nloc;
        if (old + 1u == (gen + 1u) * nloc) {
            __builtin_amdgcn_fence(__ATOMIC_RELEASE, "agent");
            asm volatile("s_waitcnt vmcnt(0)" ::: "memory");
            const unsigned og = xb_add(&bar[XB_TOP], 1u);
            const unsigned tg = og / nx;
            if (og + 1u == (tg + 1u) * nx) xb_add(&bar[XB_TOPGEN], 1u);
            else XB_SPIN(xb_ld(&bar[XB_TOPGEN]) == tg, bar);
            __builtin_amdgcn_fence(__ATOMIC_ACQUIRE, "agent");
            xb_add(&bar[XB_XGEN(x)], 1u);
            asm volatile("s_waitcnt vmcnt(0)" ::: "memory");
        } else {
            XB_SPIN(xb_ld(&bar[XB_XGEN(x)]) == gen, bar);
            __builtin_amdgcn_fence(__ATOMIC_ACQUIRE, "agent");
            asm volatile("s_waitcnt vmcnt(0)" ::: "memory");
        }
    }
    __syncthreads();
}

#define GSYNC_CG() do { asm volatile("s_waitcnt vmcnt(0)" ::: "memory"); __syncthreads(); grid.sync(); __builtin_amdgcn_fence(__ATOMIC_ACQUIRE, "agent"); asm volatile("s_waitcnt vmcnt(0)" ::: "memory"); __syncthreads(); REARG(); } while (0)
#define GSYNC() do { xcd_barrier((unsigned*)(a->ws) + 1024, (volatile LAS unsigned*)(lds + 131072 + 512)); REARG(); } while (0)
#define REARG() do { a = get_args(); ws = a->ws; HB = (bf16_t*)(ws + WS_HB); SSQ = (float*)(ws + WS_SSQ); tid = ltid(); lane = tid & 63; wave = tid >> 6; G = lgrid(); bid = lbid(); gw = bid * 8 + wave; ngw = G * 8; } while (0)
template <int I> __device__ __forceinline__ void layer_body(LAS unsigned char* lds) {
    constexpr int i = I;
    ArgP a; unsigned char* ws; bf16_t* HB; float* SSQ; int tid, lane, wave, G, bid, gw, ngw;
    REARG();
    (void)lane; (void)wave; (void)gw; (void)ngw;
        const int j = i >> 1;
        const float* hin0 = (i == 0) ? a->in[I_X] : nullptr;
        const bf16_t* mixA; int mix_lda; const bf16_t* mixB;
        if ((i & 1) == 0) {
            if (ON(2)) {
                pg8::Gemm g{HB, (const bf16_t*)(ws + WS_WIN) + (size_t)j * 2560 * 1024, T_, 2560, 1024, 1024, 1024, 1 << 20};
                pg8::StaticOrder S; S.init(T_, 2560, G, bid);
                pg8::Epi<0> E{}; E.p.ssq_in = SSQ; E.p.o1 = (bf16_t*)(ws + WS_QFIG); E.p.o2 = (bf16_t*)(ws + WS_UCAT);
                pg8::gemm_phase(lds, g, S, E);
            }
            GSYNC();
            if (ON(3)) {
                pg8::Gemm g{(const bf16_t*)(ws + WS_UCAT), (const bf16_t*)(ws + WS_EMAT) + (size_t)j * 32 * 256 * 512, T_, 256, 512, 640, 512, 4};
                pg8::StaticOrder S; S.init(T_, 256, G, bid);
                pg8::Epi<8> E{}; E.p.fout = (float*)(ws + WS_LEND);
                pg8::gemm_phase(lds, g, S, E);
                __syncthreads();
                if (ON(4)) {
                    int u0 = bid, cnt = (bid < 2048) ? (2048 - bid + G - 1) / G : 0, stp = G;
                    if (G == 256) { stp = 1; if (bid < 128) { u0 = bid * 7; cnt = 7; } else { u0 = 896 + (bid - 128) * 9; cnt = 9; } }
                    for (int q = 0; q < cnt; ++q) hg_pass1(lds, a, j, u0 + q * stp);
                }
            }
            GSYNC();
            if (ON(5)) for (int blk = bid; blk < 256; blk += G) {
                if (wave < 4) {
                    const int gt = blk * 256 + tid, bh = gt >> 12, v = (gt >> 5) & 127, kg = gt & 31;
                    bf16_t* base = (bf16_t*)(ws + WS_KVT) + (size_t)bh * 128 * 16384 + v * 128 + kg * 4;
                    const float* dbase = (const float*)(ws + WS_DBUF) + (size_t)bh * 128 * 128 + kg * 4;
                    float S4[4];
#pragma unroll
                    for (int e = 0; e < 4; ++e) S4[e] = 0.f;
                    for (int c0 = 0; c0 < 128; c0 += 16) {
                        u32x2 x[16]; f32x4 d0[16];
#pragma unroll
                        for (int q = 0; q < 16; ++q) { x[q] = *(const u32x2*)(base + (size_t)(c0 + q) * 16384); d0[q] = *(const f32x4*)(dbase + (c0 + q) * 128); }
#pragma unroll
                        for (int q = 0; q < 16; ++q) {
                            u32x2 o; o.x = pk2(S4[0], S4[1]); o.y = pk2(S4[2], S4[3]);
                            *(u32x2*)(base + (size_t)(c0 + q) * 16384) = o;
                            S4[0] = d0[q][0] * S4[0] + bflo(x[q].x); S4[1] = d0[q][1] * S4[1] + bfhi(x[q].x);
                            S4[2] = d0[q][2] * S4[2] + bflo(x[q].y); S4[3] = d0[q][3] * S4[3] + bfhi(x[q].y);
                        }
                    }
                } else if (wave == 4 && blk < 128) {
                    const int id = blk * 64 + lane, g = id >> 8, b = (id >> 6) & 3, p = id & 63;
                    const float* A32 = (const float*)(ws + WS_A32) + (size_t)(j * 32 + g) * 128;
                    const float ar = A32[p * 2], ai = A32[p * 2 + 1];
                    const size_t R0 = (size_t)g * 1024 + b * 256;
                    const float* le = (const float*)(ws + WS_LEND) + R0 * 128 + p;
                    bf16_t* uc = (bf16_t*)(ws + WS_UCAT) + R0 * 640 + 512 + p;
                    float sr = 0.f, si = 0.f;
                    for (int c0 = 0; c0 < 256; c0 += 16) {
                        float lr[16], li[16];
#pragma unroll
                        for (int q = 0; q < 16; ++q) { lr[q] = le[(size_t)(c0 + q) * 128]; li[q] = le[(size_t)(c0 + q) * 128 + 64]; }
#pragma unroll
                        for (int q = 0; q < 16; ++q) {
                            uc[(size_t)(c0 + q) * 640] = (bf16_t)f2bf(sr); uc[(size_t)(c0 + q) * 640 + 64] = (bf16_t)f2bf(si);
                            const float nr = ar * sr - ai * si + lr[q], ni = ar * si + ai * sr + li[q];
                            sr = nr; si = ni;
                        }
                    }
                }
            }
            GSYNC();
            if (ON(6)) {
                pg8::Gemm g{(const bf16_t*)(ws + WS_UCAT), (const bf16_t*)(ws + WS_BMAT) + (size_t)j * 32 * 512 * 640, T_, 512, 640, 640, 640, 4};
                pg8::StaticOrder S; S.init(T_, 512, G, bid);
                pg8::Epi<4> E{}; E.p.o1 = (bf16_t*)(ws + WS_ZBUF);
                pg8::gemm_phase(lds, g, S, E);
                __syncthreads();
                if (ON(7)) for (int u = bid; u < 2048; u += G) hg_pass3(lds, a, j, u);
            }
            GSYNC();
            if (ON(8)) {
                pg8::Gemm g{(const bf16_t*)(ws + WS_ZBUF), (const bf16_t*)(ws + WS_WGLU) + (size_t)j * 512 * 512, T_, 512, 512, 512, 512, 1 << 20};
                pg8::StaticOrder S; S.init(T_, 512, G, bid);
                pg8::Epi<5> E{}; E.p.o1 = (bf16_t*)(ws + WS_QFIG); E.p.aux = (const bf16_t*)(ws + WS_ZBUF); E.p.bias = a->in[I_BGLU] + j * 512;
                pg8::gemm_phase(lds, g, S, E);
            }
            GSYNC();
            mixA = (const bf16_t*)(ws + WS_QFIG) + 1024; mix_lda = 2048; mixB = (const bf16_t*)(ws + WS_WOUT) + (size_t)j * 1024 * 1024;
        } else {
            if (ON(9)) {
                pg8::Gemm g{HB, (const bf16_t*)(ws + WS_WQKV) + (size_t)j * 1536 * 1024, T_, 1536, 1024, 1024, 1024, 1 << 20};
                pg8::StaticOrder S; S.init(T_, 1536, G, bid);
                pg8::Epi<1> E{}; E.p.ssq_in = SSQ; E.p.o1 = (bf16_t*)(ws + WS_QKV);
                pg8::gemm_phase(lds, g, S, E);
            }
            GSYNC();
            if (ON(10)) for (int u = bid; u < 1024; u += G) attn_unit(lds, a, j, u);
            GSYNC();
            mixA = (const bf16_t*)(ws + WS_AOUT); mix_lda = 1024; mixB = (const bf16_t*)(ws + WS_WO) + (size_t)j * 1024 * 1024;
        }
        if (ON(11)) {
            pg8::Gemm g{mixA, mixB, T_, 1024, 1024, mix_lda, 1024, 1 << 20};
            pg8::StaticOrder S; S.init(T_, 1024, G, bid);
            pg8::Epi<6> E{}; E.p.hin = hin0; E.p.hb = HB; E.p.ssq_out = SSQ;
            pg8::gemm_phase(lds, g, S, E);
        }
        GSYNC();
        if (ON(12)) {
            const float* pp = a->in[I_P] + (size_t)i * T_ * 256;
            bf16_t* pb = (bf16_t*)(ws + WS_PB);
            for (size_t e = (size_t)bid * 512 + tid; e < (size_t)T_ * 256 / 8; e += (size_t)G * 512 * 4) {
                f32x4 v0[4], v1[4];
#pragma unroll
                for (int q = 0; q < 4; ++q) { const size_t ee = e + (size_t)q * G * 512; if (ee < (size_t)T_ * 256 / 8) { v0[q] = *(const f32x4*)(pp + ee * 8); v1[q] = *(const f32x4*)(pp + ee * 8 + 4); } }
#pragma unroll
                for (int q = 0; q < 4; ++q) { const size_t ee = e + (size_t)q * G * 512; if (ee < (size_t)T_ * 256 / 8) {
                    u32x4 o; o.x = pk2(v0[q][0], v0[q][1]); o.y = pk2(v0[q][2], v0[q][3]); o.z = pk2(v1[q][0], v1[q][1]); o.w = pk2(v1[q][2], v1[q][3]);
                    *(u32x4*)(pb + ee * 8) = o; } }
            }
            pg8::Gemm g{HB, (const bf16_t*)(ws + WS_W1) + (size_t)i * 4096 * 1024, T_, 4096, 1024, 1024, 1024, 1 << 20};
            pg8::StaticOrder S; S.init(T_, 4096, G, bid);
            pg8::Epi<2> E{}; E.p.ssq_in = SSQ; E.p.o1 = (bf16_t*)(ws + WS_HID);
            pg8::gemm_phase(lds, g, S, E);
        }
        GSYNC();
        if (ON(13)) {
            pg8::Gemm g{(const bf16_t*)(ws + WS_HID), (const bf16_t*)(ws + WS_W2) + (size_t)i * 4096 * 1024, T_, 1024, 4096, 4096, 4096, 1 << 20};
            pg8::StaticOrder S; S.init(T_, 1024, G, bid);
            pg8::Epi<6> E{}; E.p.hin = nullptr; E.p.hb = HB; E.p.ssq_out = SSQ;
            pg8::gemm_phase(lds, g, S, E);
        }
        GSYNC();
        if (ON(14)) {
            pg8::Gemm g{HB, (const bf16_t*)(ws + WS_WG) + (size_t)i * 1024 * 1024, T_, 1024, 1024, 1024, 1024, 1 << 20};
            pg8::StaticOrder S; S.init(T_, 1024, G, bid);
            pg8::Epi<3> E{}; E.p.ssq_in = SSQ; E.p.o1 = (bf16_t*)(ws + WS_SIG);
            pg8::gemm_phase(lds, g, S, E);
        }
        GSYNC();
        if (ON(15)) {
            pg8::Gemm g{(const bf16_t*)(ws + WS_PB), (const bf16_t*)(ws + WS_WUP) + (size_t)i * 256 * 1024, T_, 1024, 256, 256, 256, 1 << 20};
            pg8::StaticOrder S; S.init(T_, 1024, G, bid);
            pg8::Epi<7> E{}; E.p.hin = nullptr; E.p.hb = HB; E.p.ssq_out = SSQ; E.p.aux = (const bf16_t*)(ws + WS_SIG);
            pg8::gemm_phase(lds, g, S, E);
        }
        GSYNC();
    }

__global__ void __launch_bounds__(512, 2) trunk_fwd(Args a_unused) {
    ArgP a = get_args();
    extern __shared__ __attribute__((aligned(16))) unsigned char lds_raw[];
    LAS unsigned char* lds = (LAS unsigned char*)lds_raw;
    cg::grid_group grid = cg::this_grid();
    int tid = ltid(), lane = tid & 63, wave = tid >> 6;
    int G = lgrid(), bid = lbid();
    int gw = bid * 8 + wave, ngw = G * 8;
    unsigned char* ws = a->ws;
    bf16_t* HB = (bf16_t*)(ws + WS_HB);
    float* SSQ = (float*)(ws + WS_SSQ);

    if (bid == 0) { unsigned* bw_ = (unsigned*)ws + 1024; for (int q = tid; q < XCD_BAR_WORDS; q += 512) __hip_atomic_store(bw_ + q, 0u, __ATOMIC_RELAXED, __HIP_MEMORY_SCOPE_AGENT); }
    asm volatile("s_waitcnt vmcnt(0)" ::: "memory"); __syncthreads();
    grid.sync();
    if (tid == 0) { volatile LAS unsigned* st_ = (volatile LAS unsigned*)(lds + 131072 + 512); st_[0] = 0u; st_[1] = 0u;
        (void)xb_add(((unsigned*)ws + 1024) + XB_XCNT(xb_xcc_id()), 1u); }
    __syncthreads();
    if (ON(0)) for (int u = bid; u < 256; u += G) s5_tables(lds, a, u >> 7, (u >> 2) & 31, u & 3);
    if (ON(1)) {
        LAS float* scr = (LAS float*)(lds + wave * 8448);
        for (int j = 0; j < 2; ++j) {
            transpose_matrix(a->in[I_WIN] + (size_t)j * 1024 * 2560, 1024, 2560, (bf16_t*)(ws + WS_WIN) + (size_t)j * 2560 * 1024, a->in[I_MIXN] + (2 * j) * 1024, scr, gw, ngw, lane);
            transpose_matrix(a->in[I_WOUT] + (size_t)j * 1024 * 1024, 1024, 1024, (bf16_t*)(ws + WS_WOUT) + (size_t)j * 1024 * 1024, nullptr, scr, gw, ngw, lane);
            transpose_matrix(a->in[I_WGLU] + (size_t)j * 512 * 512, 512, 512, (bf16_t*)(ws + WS_WGLU) + (size_t)j * 512 * 512, nullptr, scr, gw, ngw, lane);
            transpose_matrix(a->in[I_WQKV] + (size_t)j * 1024 * 1536, 1024, 1536, (bf16_t*)(ws + WS_WQKV) + (size_t)j * 1536 * 1024, a->in[I_MIXN] + (2 * j + 1) * 1024, scr, gw, ngw, lane);
            transpose_matrix(a->in[I_WO] + (size_t)j * 1024 * 1024, 1024, 1024, (bf16_t*)(ws + WS_WO) + (size_t)j * 1024 * 1024, nullptr, scr, gw, ngw, lane);
        }
        for (int i = 0; i < 4; ++i) {
            transpose_matrix(a->in[I_W1] + (size_t)i * 1024 * 4096, 1024, 4096, (bf16_t*)(ws + WS_W1) + (size_t)i * 4096 * 1024, a->in[I_MLPN] + i * 1024, scr, gw, ngw, lane);
            transpose_matrix(a->in[I_W2] + (size_t)i * 4096 * 1024, 4096, 1024, (bf16_t*)(ws + WS_W2) + (size_t)i * 4096 * 1024, nullptr, scr, gw, ngw, lane);
            transpose_matrix(a->in[I_WUP] + (size_t)i * 256 * 1024, 256, 1024, (bf16_t*)(ws + WS_WUP) + (size_t)i * 256 * 1024, nullptr, scr, gw, ngw, lane);
            transpose_matrix(a->in[I_WG] + (size_t)i * 1024 * 1024, 1024, 1024, (bf16_t*)(ws + WS_WG) + (size_t)i * 1024 * 1024, a->in[I_PLEN] + i * 1024, scr, gw, ngw, lane);
        }
    }
    for (int r = gw; r < T_; r += ngw) {
        const f32x4* xr = (const f32x4*)(a->in[I_X] + (size_t)r * 1024) + lane;
        float s = 0.f;
        unsigned long long* o8 = (unsigned long long*)(HB + (size_t)r * 1024) + lane;
        f32x4 xv[4];
#pragma unroll
        for (int q = 0; q < 4; ++q) xv[q] = xr[64 * q];
#pragma unroll
        for (int q = 0; q < 4; ++q) { const f32x4 v = xv[q]; s += (v[0] * v[0] + v[1] * v[1]) + (v[2] * v[2] + v[3] * v[3]);
            o8[64 * q] = (unsigned long long)pk2(v[0], v[1]) | ((unsigned long long)pk2(v[2], v[3]) << 32); }
        s = wave_sum(s);
        if (lane < 16) SSQ[(size_t)r * 16 + lane] = (lane == 0) ? s : 0.f;
    }
    GSYNC();


    layer_body<0>(lds); REARG();
    layer_body<1>(lds); REARG();
    layer_body<2>(lds); REARG();
    layer_body<3>(lds); REARG();
    for (int r = gw; r < T_; r += ngw) {
        const float rs = row_rstd(SSQ, r);
        f32x4* xr = (f32x4*)(a->out + (size_t)r * 1024) + lane;
        const u32x2* hr = (const u32x2*)(HB + (size_t)r * 1024) + lane;
        const f32x4* gr = (const f32x4*)a->in[I_FINN] + lane;
        u32x2 hw4[4]; f32x4 gg4[4];
#pragma unroll
        for (int q = 0; q < 4; ++q) { hw4[q] = hr[64 * q]; gg4[q] = gr[64 * q]; }
#pragma unroll
        for (int q = 0; q < 4; ++q) { const u32x2 hw = hw4[q]; f32x4 v; v[0] = bflo(hw.x); v[1] = bfhi(hw.x); v[2] = bflo(hw.y); v[3] = bfhi(hw.y); v = v * rs * gg4[q]; xr[64 * q] = v; }
    }
}

extern "C" void kernel_launch(void* const* d_in, const int* in_sizes, int n_in, void* d_out, int out_size, void* d_ws, size_t ws_size, hipStream_t stream) {
    static int grid = 0;
    if (grid == 0) {
        if (n_in != 27 || ws_size < WS_END) { fprintf(stderr, "kernel_launch: unexpected n_in %d / ws_size %zu (need %zu)\n", n_in, ws_size, (size_t)WS_END); grid = -1; return; }
        int dev = 0, cus = 0, per_cu = 0;
        hipGetDevice(&dev);
        hipDeviceGetAttribute(&cus, hipDeviceAttributeMultiprocessorCount, dev);
        hipFuncSetAttribute((const void*)trunk_fwd, hipFuncAttributeMaxDynamicSharedMemorySize, LDS_BYTES);
        hipOccupancyMaxActiveBlocksPerMultiprocessor(&per_cu, (const void*)trunk_fwd, 512, LDS_BYTES);
        if (per_cu < 1) per_cu = 1;
        grid = cus * per_cu;
        (void)hipGetLastError();
    }
    if (grid < 0) return;
    Args a{};
    for (int i = 0; i < 27; ++i) a.in[i] = (const float*)d_in[i];
    a.out = (float*)d_out; a.ws = (unsigned char*)d_ws;
    void* args[] = {&a};
    hipError_t e = hipLaunchCooperativeKernel((const void*)trunk_fwd, dim3(grid), dim3(512), args, LDS_BYTES, stream);
    if (e != hipSuccess) fprintf(stderr, "cooperative launch failed: %s (grid %d)\n", hipGetErrorString(e), grid);
}
```
